# Optimizing an MI355X kernel written in HIP

```python
import math
import jax, jax.numpy as jnp
from jax import lax
import numpy as np


D_MODEL = 1024
BATCH = 1
SEQ = 16384
DEPTH = 2

N_MIXERS = 2
N_A_LAYERS = (DEPTH + 1) // 2
N_B_LAYERS = DEPTH // 2
N_SUBLAYERS = 3
RMS_EPS = 1e-6

D_FF = 2816

GM_D = 3 * D_MODEL
GM_GROUPS = 16
GM_GROUP_DIM = GM_D // GM_GROUPS
GM_CHUNK = 128

MB_HEADS = 16
MB_HEAD_DIM = D_MODEL // MB_HEADS
MB_BLOCK = 256
MB_TOPK = 3
MB_QBLOCK = 128
MB_SCALE = MB_HEAD_DIM ** -0.5

T5_NUM_BUCKETS = 32
T5_MAX_EXACT = T5_NUM_BUCKETS // 2
T5_MAX_DISTANCE = 128

NEG_INF = -1e30

kernel_name = "hybrid_gmlp_moba_macaron_adaln"


def rmsnorm(x, g):
    xf = x.astype(jnp.float32)
    y = xf * lax.rsqrt(jnp.mean(xf * xf, axis=-1, keepdims=True) + RMS_EPS)
    return (y * g.astype(jnp.float32)).astype(x.dtype)


def adaln(x, g, shift, scale):
    return rmsnorm(x, g) * (1 + scale[:, None, :]) + shift[:, None, :]


def swiglu(h, w_in, w_out):
    gate, up = jnp.split(h @ w_in, 2, axis=-1)
    return (jax.nn.silu(gate) * up) @ w_out


def t5_bucket(rel):
    n = jnp.maximum(rel, 0)
    is_small = n < T5_MAX_EXACT
    nf = jnp.maximum(n, T5_MAX_EXACT).astype(jnp.float32)
    large = T5_MAX_EXACT + (jnp.log(nf / T5_MAX_EXACT)
                            / math.log(T5_MAX_DISTANCE / T5_MAX_EXACT)
                            * (T5_NUM_BUCKETS - T5_MAX_EXACT)).astype(jnp.int32)
    large = jnp.minimum(large, T5_NUM_BUCKETS - 1)
    return jnp.where(is_small, n, large)


def gmlp_mixer(h, w_in, v_norm, w_s, b_s, w_out):
    B, S, _ = h.shape
    z = jax.nn.gelu(h @ w_in, approximate=False)
    u, v = jnp.split(z, 2, axis=-1)
    v = rmsnorm(v, v_norm).reshape(B, S // GM_CHUNK, GM_CHUNK, GM_GROUPS, GM_GROUP_DIM)
    causal = jnp.tril(jnp.ones((GM_CHUNK, GM_CHUNK), dtype=bool))
    w_sm = jnp.where(causal, w_s, 0)
    sv = jnp.einsum("gts,bcsgd->bctgd", w_sm, v) + b_s.T[:, :, None]
    return (u * sv.reshape(B, S, GM_D)) @ w_out


def moba_mixer(h, w_qkv, w_o, rel_bias):
    B, S, _ = h.shape
    qkv = (h @ w_qkv).reshape(B, S, 3, MB_HEADS, MB_HEAD_DIM)
    q = qkv[:, :, 0].transpose(0, 2, 1, 3)
    k = qkv[:, :, 1].transpose(0, 2, 1, 3)
    v = qkv[:, :, 2].transpose(0, 2, 1, 3)
    nb = -(-S // MB_BLOCK)
    pad = ((0, 0), (0, 0), (0, nb * MB_BLOCK - S), (0, 0))
    k = jnp.pad(k, pad)
    v = jnp.pad(v, pad)
    k_blocks = k.reshape(B, MB_HEADS, nb, MB_BLOCK, MB_HEAD_DIM)
    v_blocks = v.reshape(B, MB_HEADS, nb, MB_BLOCK, MB_HEAD_DIM)
    k_mean = jnp.mean(k_blocks.astype(jnp.float32), axis=3)
    topk = min(MB_TOPK, nb)
    b_ix = jnp.arange(B)[:, None, None, None]
    h_ix = jnp.arange(MB_HEADS)[None, :, None, None]
    blk_ar = jnp.arange(nb)
    slot_ar = jnp.arange(topk)
    key_ar = jnp.arange(MB_BLOCK)
    q_ar = jnp.arange(MB_QBLOCK)

    def one_query_block(qb):
        p0 = qb * MB_QBLOCK
        j = p0 // MB_BLOCK
        q_blk = lax.dynamic_slice_in_dim(q, p0, MB_QBLOCK, axis=2)
        q_pos = p0 + q_ar
        gate = jnp.einsum("bhqd,bhnd->bhqn", q_blk.astype(jnp.float32), k_mean)
        gate = jnp.where(blk_ar < j, gate, NEG_INF)
        _, idx = lax.top_k(gate, topk)
        k_sel = k_blocks[b_ix, h_ix, idx]
        v_sel = v_blocks[b_ix, h_ix, idx]
        logit_sel = jnp.einsum("bhqd,bhqrkd->bhqrk", q_blk, k_sel).astype(jnp.float32) * MB_SCALE
        k_pos_sel = idx[..., None] * MB_BLOCK + key_ar
        bucket_sel = t5_bucket(q_pos[:, None, None] - k_pos_sel)
        logit_sel = logit_sel + rel_bias[bucket_sel, h_ix[..., None]].astype(jnp.float32)
        logit_sel = jnp.where((slot_ar < j)[:, None], logit_sel, NEG_INF)
        k_own = lax.dynamic_slice_in_dim(k, j * MB_BLOCK, MB_BLOCK, axis=2)
        v_own = lax.dynamic_slice_in_dim(v, j * MB_BLOCK, MB_BLOCK, axis=2)
        logit_own = jnp.einsum("bhqd,bhkd->bhqk", q_blk, k_own).astype(jnp.float32) * MB_SCALE
        rel_own = q_pos[:, None] - (j * MB_BLOCK + key_ar)[None, :]
        logit_own = logit_own + rel_bias[t5_bucket(rel_own)].transpose(2, 0, 1).astype(jnp.float32)
        logit_own = jnp.where(rel_own >= 0, logit_own, NEG_INF)
        logits = jnp.concatenate(
            [logit_sel.reshape(B, MB_HEADS, MB_QBLOCK, topk * MB_BLOCK), logit_own], axis=-1)
        p = jax.nn.softmax(logits, axis=-1).astype(v.dtype)
        p_sel = p[..., : topk * MB_BLOCK].reshape(B, MB_HEADS, MB_QBLOCK, topk, MB_BLOCK)
        p_own = p[..., topk * MB_BLOCK:]
        return (jnp.einsum("bhqrk,bhqrkd->bhqd", p_sel, v_sel)
                + jnp.einsum("bhqk,bhkd->bhqd", p_own, v_own))

    o = lax.map(one_query_block, jnp.arange(S // MB_QBLOCK))
    o = o.transpose(1, 0, 3, 2, 4).reshape(B, S, MB_HEADS * MB_HEAD_DIM)
    return o @ w_o


def setup_inputs(seed: int = 0) -> dict:
    key = jax.random.key(seed)
    ks = jax.random.split(key, 16)
    f32 = jnp.float32

    def nrm(k, shape, scale):
        return jax.random.normal(k, shape, f32) * scale

    return {
        "x": nrm(ks[0], (BATCH, SEQ, D_MODEL), 1.0),
        "c": nrm(ks[1], (BATCH, D_MODEL), 1.0),
        "rel_bias": nrm(ks[2], (T5_NUM_BUCKETS, MB_HEADS), 0.5),
        "mod_w": nrm(ks[3], (DEPTH, D_MODEL, N_SUBLAYERS * 3 * D_MODEL), D_MODEL ** -0.5),
        "mod_b": nrm(ks[4], (DEPTH, N_SUBLAYERS * 3 * D_MODEL), 0.02),
        "norm_g": 1.0 + nrm(ks[5], (DEPTH, N_SUBLAYERS, D_MODEL), 0.02),
        "ffn_w_in": nrm(ks[6], (DEPTH, 2, D_MODEL, 2 * D_FF), D_MODEL ** -0.5),
        "ffn_w_out": nrm(ks[7], (DEPTH, 2, D_FF, D_MODEL), D_FF ** -0.5),
        "gmlp_w_in": nrm(ks[8], (N_A_LAYERS, D_MODEL, 2 * GM_D), D_MODEL ** -0.5),
        "gmlp_v_norm": 1.0 + nrm(ks[9], (N_A_LAYERS, GM_D), 0.02),
        "gmlp_w_s": nrm(ks[10], (N_A_LAYERS, GM_GROUPS, GM_CHUNK, GM_CHUNK), GM_CHUNK ** -0.5),
        "gmlp_b_s": 1.0 + nrm(ks[11], (N_A_LAYERS, GM_GROUPS, GM_CHUNK), 0.02),
        "gmlp_w_out": nrm(ks[12], (N_A_LAYERS, GM_D, D_MODEL), GM_D ** -0.5),
        "moba_w_qkv": nrm(ks[13], (N_B_LAYERS, D_MODEL, 3 * D_MODEL), D_MODEL ** -0.5),
        "moba_w_o": nrm(ks[14], (N_B_LAYERS, D_MODEL, D_MODEL), D_MODEL ** -0.5),
        "final_norm": 1.0 + nrm(ks[15], (D_MODEL,), 0.02),
    }


def reference(x, c, rel_bias, mod_w, mod_b, norm_g, ffn_w_in, ffn_w_out,
              gmlp_w_in, gmlp_v_norm, gmlp_w_s, gmlp_b_s, gmlp_w_out,
              moba_w_qkv, moba_w_o, final_norm):
    B = x.shape[0]
    c_act = jax.nn.silu(c)
    for i in range(DEPTH):
        mod = (c_act @ mod_w[i] + mod_b[i]).reshape(B, N_SUBLAYERS, 3, D_MODEL)
        h = adaln(x, norm_g[i, 0], mod[:, 0, 0], mod[:, 0, 1])
        x = x + 0.5 * mod[:, 0, 2][:, None, :] * swiglu(h, ffn_w_in[i, 0], ffn_w_out[i, 0])
        h = adaln(x, norm_g[i, 1], mod[:, 1, 0], mod[:, 1, 1])
        li = i // N_MIXERS
        if i % N_MIXERS == 0:
            y = gmlp_mixer(h, gmlp_w_in[li], gmlp_v_norm[li], gmlp_w_s[li], gmlp_b_s[li], gmlp_w_out[li])
        else:
            y = moba_mixer(h, moba_w_qkv[li], moba_w_o[li], rel_bias)
        x = x + mod[:, 1, 2][:, None, :] * y
        h = adaln(x, norm_g[i, 2], mod[:, 2, 0], mod[:, 2, 1])
        x = x + 0.5 * mod[:, 2, 2][:, None, :] * swiglu(h, ffn_w_in[i, 1], ffn_w_out[i, 1])
    return rmsnorm(x, final_norm)
```

```cpp
#include <hip/hip_runtime.h>
#include <hip/hip_cooperative_groups.h>
#include <cstdio>
#include <cstdint>
namespace cg = cooperative_groups;

#ifndef MK_MULTI
#define MK_MULTI 0
#endif

#ifndef PROBE_DUP
#define PROBE_DUP -1
#endif

#ifndef PROBE_REP
#define PROBE_REP 1
#endif
#ifndef PROBE_MFMA
#define PROBE_MFMA 0
#endif
#ifndef PROBE_ATT
#define PROBE_ATT 0
#endif
#ifndef LOCAL_SEAMS
#define LOCAL_SEAMS 1
#endif
#ifndef PROBE_NOPS
#define PROBE_NOPS 0
#endif
#ifndef PROBE_SKIPEPI
#define PROBE_SKIPEPI 0
#endif
#define LAS __attribute__((address_space(3)))
typedef unsigned short bf16_t;
typedef short bf16x8 __attribute__((ext_vector_type(8)));
typedef float f32x2 __attribute__((ext_vector_type(2)));
typedef float f32x4 __attribute__((ext_vector_type(4)));
typedef float f32x16 __attribute__((ext_vector_type(16)));
typedef unsigned u32x2 __attribute__((ext_vector_type(2)));
typedef unsigned u32x4 __attribute__((ext_vector_type(4)));

constexpr int SEQ = 16384, DM = 1024, DFF = 2816, GMD = 3072, NH = 16, HD = 64;
constexpr int NFF2 = 2 * DFF;
constexpr float RMS_EPS = 1e-6f;
constexpr float LOG2E = 1.4426950408889634f;
constexpr float QSCALE = 0.125f * LOG2E;
constexpr int NTHREADS = 512, NWAVES = 8;

constexpr size_t KiB = 1024, MiB = 1u << 20;
constexpr size_t WS_CTL = 0, CTL_BYTES = 256 * KiB;
constexpr size_t WS_BAR = 16 * KiB;
constexpr size_t WS_MOD = 256 * KiB;
constexpr size_t WS_GAM = 328 * KiB;
constexpr size_t WS_BIASF = 352 * KiB;
constexpr size_t WS_BIASG = 440 * KiB;
constexpr size_t WS_BIASQ = 464 * KiB;
constexpr size_t WS_TAB = 476 * KiB;
constexpr size_t WS_GATE = 484 * KiB;
constexpr size_t WS_KSUM = 512 * KiB;
constexpr size_t WS_SUMSQ = 1 * MiB;
constexpr size_t WS_VSQ = 2 * MiB;
constexpr size_t WS_W1 = 5 * MiB;
constexpr size_t WS_W0 = 46 * MiB;
constexpr size_t WS_BIG = 100 * MiB;
constexpr size_t WS_ZV = 188 * MiB;
constexpr size_t WS_XB = 284 * MiB;
constexpr size_t WS_BPART = 316 * MiB;
constexpr size_t WS_END = 318 * MiB;
constexpr int BP_F = 0, BP_G = 4 * 16 * 5632, BP_Q = BP_G + 16 * 6144;
constexpr size_t SZ_FIN = 11 * MiB, SZ_FOUT = 5767168;
constexpr size_t W1_FIN = WS_W1, W1_FOUT = WS_W1 + 22 * MiB, W1_QKV = WS_W1 + 33 * MiB, W1_WO = WS_W1 + 39 * MiB;
constexpr size_t W0_FIN = WS_W0, W0_FOUT = WS_W0 + 22 * MiB, W0_GIN = WS_W0 + 33 * MiB, W0_GOUT = WS_W0 + 45 * MiB;
constexpr size_t AT_LIST = 46 * MiB;
constexpr size_t AT_ML = 62 * MiB;
constexpr size_t AT_Q = 68 * MiB, AT_K = 100 * MiB, AT_V = 132 * MiB;
constexpr size_t AT_PO = 164 * MiB;
static_assert(AT_PO + 96 * MiB <= WS_XB, "ws map");
constexpr int LIST_PER_HEAD = 516096;

constexpr int RING_BYTES = 131072;
constexpr int LDS_BYTES = 147456;

__device__ __forceinline__ unsigned cvt_pk_bf16(float lo, float hi) { unsigned r; asm volatile("v_cvt_pk_bf16_f32 %0, %1, %2" : "=v"(r) : "v"(lo), "v"(hi)); return r; }
__device__ __forceinline__ float bf_lo(unsigned w) { return __uint_as_float(w << 16); }
__device__ __forceinline__ float bf_hi(unsigned w) { return __uint_as_float(w & 0xffff0000u); }
__device__ __forceinline__ float bf2f(bf16_t b) { return __uint_as_float(((unsigned)b) << 16); }
__device__ __forceinline__ float fast_exp2(float x) { return __builtin_amdgcn_exp2f(x); }
__device__ __forceinline__ float fast_rcp(float x) { return __builtin_amdgcn_rcpf(x); }
__device__ __forceinline__ float silu_f(float g) { return g * fast_rcp(1.0f + fast_exp2(-g * LOG2E)); }
#ifndef WT_STORES
#define WT_STORES 0
#endif
__device__ __forceinline__ void st16(void* p, u32x4 v) {
#if WT_STORES
    asm volatile("global_store_dwordx4 %0, %1, off sc1\n\ts_nop 1" :: "v"(p), "v"(v) : "memory");
#else
    *(u32x4*)p = v;
#endif
}
__device__ __forceinline__ void st8(void* p, u32x2 v) {
#if WT_STORES
    asm volatile("global_store_dwordx2 %0, %1, off sc1\n\ts_nop 1" :: "v"(p), "v"(v) : "memory");
#else
    *(u32x2*)p = v;
#endif
}
__device__ __forceinline__ float wave_sum(float v) {
#pragma unroll
    for (int o = 1; o < 64; o <<= 1) v += __shfl_xor(v, o);
    return v;
}
__device__ __forceinline__ float row_rstd16(const float* sumsq, int row) {
    const f32x4* p = (const f32x4*)(sumsq + (size_t)row * 16);
    const f32x4 a = p[0], b = p[1], c = p[2], d = p[3];
    const float s = ((a.x + a.y) + (a.z + a.w)) + ((b.x + b.y) + (b.z + b.w)) + ((c.x + c.y) + (c.z + c.w)) + ((d.x + d.y) + (d.z + d.w));
    return rsqrtf(s * (1.0f / DM) + RMS_EPS);
}
__device__ __forceinline__ f32x2 gelu_pk(f32x2 v) {
    const f32x2 av = __builtin_elementwise_abs(v), d = av * 0.2316418882f + 1.0f;
    f32x2 t; t.x = __builtin_amdgcn_rcpf(d.x); t.y = __builtin_amdgcn_rcpf(d.y);
    f32x2 q = t * 0.5307027145f + (-0.7265760135f); q = q * t + 0.7107068705f; q = q * t + (-0.142248368f); q = q * t + 0.127414796f; q = q * t;
    const f32x2 s = (v * v) * (-0.72134752044f);
    f32x2 e; e.x = __builtin_amdgcn_exp2f(s.x); e.y = __builtin_amdgcn_exp2f(s.y);
    const f32x2 m = v * (q * e), r = v - m;
    f32x2 o; o.x = v.x < 0.f ? m.x : r.x; o.y = v.y < 0.f ? m.y : r.y; return o;
}
__device__ __forceinline__ f32x4 gelu4(f32x4 v) { const f32x2 a = gelu_pk((f32x2){v[0], v[1]}), b = gelu_pk((f32x2){v[2], v[3]}); return (f32x4){a.x, a.y, b.x, b.y}; }

namespace pg8 {
constexpr int BM = 256, BK = 64, HALF = 128, HTB = HALF * BK * 2, NXCD = 8, WGM = 8;
__host__ __device__ __forceinline__ int lds_byte(int r, int c) { const int st = (r >> 4) * 2 + (c >> 5), rr = r & 15, cc = c & 31, ob = rr * 64 + cc * 2; return st * 1024 + (ob ^ (((ob >> 9) & 1) << 5)); }
__host__ __device__ __forceinline__ void stage_rc(int b, int& R, int& C) { const int st = b / 1024, sb = b % 1024, swz = sb ^ (((sb >> 9) & 1) << 5); R = (st >> 1) * 16 + swz / 64; C = (st & 1) * 32 + (swz % 64) / 2; }
__host__ __device__ __forceinline__ int perm32(int rho) { const int n = rho >> 4, i = rho & 15; return 8 * (i >> 2) + 4 * n + (i & 3); }

struct Unit { int pm, pn, idx; };
struct Gemm { const bf16_t* A; const bf16_t* Bt; int M, N, K; int lda; size_t kstepA; };

struct StaticOrder {
    int nM, nN, nwg, G, c;
    __device__ void init(int M, int N, int G_, int c_) { nM = M / BM; nN = N / BM; nwg = nM * nN; G = G_; c = c_; }
    __device__ bool next(int i, Unit& u) const {
        const long L = (long)i * G + c; if (L >= nwg) return false;
        int wgid = (int)L; { const int q = nwg / NXCD, r = nwg % NXCD, xcd = wgid % NXCD, off = wgid / NXCD; wgid = (xcd < r ? xcd * (q + 1) : r * (q + 1) + (xcd - r) * q) + off; }
        const int nig = WGM * nN, gid = wgid / nig, fm = gid * WGM, gsz = (nM - fm) < WGM ? (nM - fm) : WGM;
        u.pm = fm + ((wgid % nig) % gsz); u.pn = (wgid % nig) / gsz; u.idx = i; return true;
    }
};

template <class Epi, bool ALIGN_EPI>
__device__ __forceinline__ void gemm_phase(LAS unsigned char* lds, const Gemm g, const StaticOrder& S, const Epi& E, const int tid, const bool skip_epi = false) {
    const int wid = __builtin_amdgcn_readfirstlane(tid >> 6), lane = tid & 63, wr = wid >> 2, wc = wid & 3, fr = lane & 15, fq = lane >> 4;
    const int K = g.K, nt = K / BK;
    unsigned voffA[2], voffB[2];
#pragma unroll
    for (int i = 0; i < 2; ++i) { int R, C; stage_rc(tid * 16 + i * 8192, R, C); const int Rb = Epi::PERM ? ((R & ~31) + perm32(R & 31)) : R;
        voffA[i] = (unsigned)(R * g.lda + C) * 2u; voffB[i] = (unsigned)(Rb * K + C) * 2u; }
    const size_t kstepA = g.kstepA, kstepB = (size_t)(BK * 2);
    const size_t hstepA = (size_t)HALF * g.lda * 2, hstepB = (size_t)HALF * K * 2;
    const size_t tstepA = 2 * hstepA, tstepB = 2 * hstepB;
    const unsigned ldsw = (unsigned)wid * 1024u;
    const int aoff = lds_byte(wr * 64 + fr, fq * 8), boff = lds_byte(wc * 32 + fr, fq * 8);
#define PG8_SA(b, h) (((b) * 2 + (h)) * HTB)
#define PG8_SB(b, h) ((4 + (b) * 2 + (h)) * HTB)
#define PG8_STAGE(bufoff, gbase, voff) do { _Pragma("unroll") for (int _i = 0; _i < 2; ++_i) \
        __builtin_amdgcn_global_load_lds((const unsigned*)((const char*)(gbase) + (voff)[_i]), (LAS unsigned*)(lds + (bufoff) + ldsw + _i * 8192), 16, 0, 0); } while (0)
#define PG8_LDA(dst, b, h) do { _Pragma("unroll") for (int m = 0; m < 4; ++m) _Pragma("unroll") for (int k = 0; k < 2; ++k) dst[m][k] = *(const LAS bf16x8*)(lds + PG8_SA(b, h) + aoff + m * 2048 + k * 1024); } while (0)
#define PG8_LDB(dst, b, h) do { _Pragma("unroll") for (int n = 0; n < 2; ++n) _Pragma("unroll") for (int k = 0; k < 2; ++k) dst[n][k] = *(const LAS bf16x8*)(lds + PG8_SB(b, h) + boff + n * 2048 + k * 1024); } while (0)
#define PG8_MMA(ai, bj, At, Bt) do { __builtin_amdgcn_s_setprio(1); _Pragma("unroll") for (int m = 0; m < 4; ++m) _Pragma("unroll") for (int n = 0; n < 2; ++n) _Pragma("unroll") for (int k = 0; k < 2; ++k) \
        acc[ai][bj][m][n] = __builtin_amdgcn_mfma_f32_16x16x32_bf16(Bt[n][k], At[m][k], acc[ai][bj][m][n], 0, 0, 0); __builtin_amdgcn_s_setprio(0); } while (0)
#define PG8_WAIT_V(n) asm volatile("s_waitcnt vmcnt(" #n ")" ::: "memory")
#define PG8_WAIT_L(n) asm volatile("s_waitcnt lgkmcnt(" #n ")" ::: "memory")
#define PG8_BAR __builtin_amdgcn_s_barrier()
#define PG8_SCHED __builtin_amdgcn_sched_barrier(0)
    Unit cur, nxt; int ui = 0;
    if (!S.next(0, cur)) return;
    f32x4 acc[2][2][4][2];
#pragma unroll
    for (int a = 0; a < 2; ++a)
#pragma unroll
        for (int b = 0; b < 2; ++b)
#pragma unroll
            for (int m = 0; m < 4; ++m)
#pragma unroll
                for (int n = 0; n < 2; ++n) acc[a][b][m][n] = (f32x4){0.f, 0.f, 0.f, 0.f};
    bf16x8 At[4][2], B0[2][2], B1[2][2];
    const char* cA = (const char*)g.A + (size_t)cur.pm * tstepA; const char* cB = (const char*)g.Bt + (size_t)cur.pn * tstepB;
    PG8_STAGE(PG8_SB(0, 0), cB, voffB); PG8_STAGE(PG8_SB(0, 1), cB + hstepB, voffB); PG8_STAGE(PG8_SA(0, 0), cA, voffA); PG8_STAGE(PG8_SA(0, 1), cA + hstepA, voffA);
    if (wr == 1) PG8_BAR;
    PG8_WAIT_V(2); PG8_BAR;
    PG8_STAGE(PG8_SB(1, 0), cB + kstepB, voffB); PG8_STAGE(PG8_SA(1, 0), cA + kstepA, voffA); PG8_STAGE(PG8_SB(1, 1), cB + hstepB + kstepB, voffB);
    PG8_WAIT_V(6); PG8_BAR;
    for (;;) {
        const bool has_next = S.next(ui + 1, nxt);
        const char* nA = has_next ? (const char*)g.A + (size_t)nxt.pm * tstepA : cA; const char* nB = has_next ? (const char*)g.Bt + (size_t)nxt.pn * tstepB : cB;
        for (int t = 0; t < nt; t += 2) {
            const bool last = (t == nt - 2);
            const char* a1 = cA + (size_t)(t + 1) * kstepA;
            const char* a2 = last ? nA : cA + (size_t)(t + 2) * kstepA; const char* b2 = last ? nB : cB + (size_t)(t + 2) * kstepB;
            const char* a3 = a2 + kstepA; const char* b3 = b2 + kstepB;
            PG8_LDB(B0, 0, 0); PG8_LDB(B1, 0, 1); PG8_SCHED; PG8_LDA(At, 0, 0); PG8_STAGE(PG8_SA(1, 1), a1 + hstepA, voffA);
            PG8_WAIT_V(8); PG8_WAIT_L(0); PG8_BAR; PG8_MMA(0, 0, At, B0); PG8_MMA(0, 1, At, B1); PG8_BAR; PG8_SCHED;
            PG8_LDA(At, 0, 1); PG8_STAGE(PG8_SB(0, 0), b2, voffB); PG8_STAGE(PG8_SB(0, 1), b2 + hstepB, voffB); PG8_STAGE(PG8_SA(0, 0), a2, voffA);
            PG8_WAIT_V(8); PG8_WAIT_L(0); PG8_BAR; PG8_MMA(1, 0, At, B0); PG8_MMA(1, 1, At, B1); PG8_BAR; PG8_SCHED;
            PG8_LDB(B0, 1, 0); PG8_LDB(B1, 1, 1); PG8_SCHED; PG8_LDA(At, 1, 0); PG8_STAGE(PG8_SA(0, 1), a2 + hstepA, voffA);
            PG8_WAIT_V(8); PG8_WAIT_L(0); PG8_BAR; PG8_MMA(0, 0, At, B0); PG8_MMA(0, 1, At, B1); PG8_BAR; PG8_SCHED;
            PG8_LDA(At, 1, 1); PG8_STAGE(PG8_SB(1, 0), b3, voffB); PG8_STAGE(PG8_SB(1, 1), b3 + hstepB, voffB); PG8_STAGE(PG8_SA(1, 0), a3, voffA);
            PG8_WAIT_V(8); PG8_WAIT_L(0); PG8_BAR; PG8_MMA(1, 0, At, B0); PG8_MMA(1, 1, At, B1); PG8_BAR; PG8_SCHED;
        }
        if constexpr (ALIGN_EPI) { if (wr == 0) PG8_BAR; }
        if (!(PROBE_SKIPEPI && skip_epi)) E(acc, cur, wr, wc, fr, fq);
        if (!has_next) break;
#pragma unroll
        for (int a = 0; a < 2; ++a)
#pragma unroll
            for (int b = 0; b < 2; ++b)
#pragma unroll
                for (int m = 0; m < 4; ++m)
#pragma unroll
                    for (int n = 0; n < 2; ++n) acc[a][b][m][n] = (f32x4){0.f, 0.f, 0.f, 0.f};
        cur = nxt; cA = nA; cB = nB; ++ui;
        if constexpr (ALIGN_EPI) { if (wr == 1) PG8_BAR; }
    }
    PG8_WAIT_V(0);
    if constexpr (!ALIGN_EPI) { if (wr == 0) PG8_BAR; }
    PG8_BAR;
#undef PG8_SA
#undef PG8_SB
#undef PG8_STAGE
#undef PG8_LDA
#undef PG8_LDB
#undef PG8_MMA
#undef PG8_WAIT_V
#undef PG8_WAIT_L
#undef PG8_BAR
#undef PG8_SCHED
}

struct EpiSwiGLU {
    static constexpr bool PERM = true;
    bf16_t* O; const LAS float* bias; const LAS float* rst;
    __device__ __forceinline__ void operator()(const f32x4 (&acc)[2][2][4][2], const Unit& u, int wr, int wc, int fr, int fq) const {
        const int row0 = u.pm * BM + wr * 64 + fr, f0 = u.pn * 128 + wc * 32 + 8 * fq;
        const LAS float* bp = bias + u.idx * 256 + wc * 32 + 8 * fq;
        const f32x4 bg0 = *(const LAS f32x4*)(bp), bg1 = *(const LAS f32x4*)(bp + 4), bu0 = *(const LAS f32x4*)(bp + 128), bu1 = *(const LAS f32x4*)(bp + 132);
#pragma unroll
        for (int ai = 0; ai < 2; ++ai)
#pragma unroll
            for (int m = 0; m < 4; ++m) {
                const int row = row0 + ai * HALF + m * 16; const float rs = rst[(u.pm & 7) * 256 + ai * HALF + wr * 64 + m * 16 + fr];
                const f32x2 rs2 = (f32x2){rs, rs};
                u32x4 w;
#pragma unroll
                for (int n = 0; n < 2; ++n) {
                    const f32x4 ag = acc[ai][0][m][n], au = acc[ai][1][m][n], bgv = n ? bg1 : bg0, buv = n ? bu1 : bu0;
                    unsigned pk[2];
#pragma unroll
                    for (int hh = 0; hh < 2; ++hh) {
                        const f32x2 g = (f32x2){ag[2 * hh], ag[2 * hh + 1]} * rs2 + (f32x2){bgv[2 * hh], bgv[2 * hh + 1]};
                        const f32x2 uu = (f32x2){au[2 * hh], au[2 * hh + 1]} * rs2 + (f32x2){buv[2 * hh], buv[2 * hh + 1]};
                        const f32x2 t = g * (-LOG2E);
                        f32x2 e; e.x = fast_exp2(t.x); e.y = fast_exp2(t.y);
                        const f32x2 d = e + 1.0f;
                        f32x2 r; r.x = fast_rcp(d.x); r.y = fast_rcp(d.y);
                        const f32x2 hv = (g * uu) * r;
                        pk[hh] = cvt_pk_bf16(hv.x, hv.y);
                    }
                    if (n == 0) { w.x = pk[0]; w.y = pk[1]; } else { w.z = pk[0]; w.w = pk[1]; }
                }
                st16(O + (size_t)row * DFF + f0, w);
                asm volatile("" ::: "memory");
            }
    }
};
struct EpiResid {
    static constexpr bool PERM = true;
    bf16_t* xb; const float* gate; float* sumsq;
    __device__ __forceinline__ void operator()(const f32x4 (&acc)[2][2][4][2], const Unit& u, int wr, int wc, int fr, int fq) const {
        const int row0 = u.pm * BM + wr * 64 + fr, c0 = u.pn * BM + wc * 32 + 8 * fq;
        f32x4 gv[2][2];
#pragma unroll
        for (int bj = 0; bj < 2; ++bj)
#pragma unroll
            for (int n = 0; n < 2; ++n) gv[bj][n] = *(const f32x4*)(gate + c0 + bj * HALF + 4 * n);
#pragma unroll
        for (int ai = 0; ai < 2; ++ai) {
            u32x4 xs[4][2];
#pragma unroll
            for (int m = 0; m < 4; ++m)
#pragma unroll
                for (int bj = 0; bj < 2; ++bj) xs[m][bj] = *(const u32x4*)(xb + (size_t)(row0 + ai * HALF + m * 16) * DM + c0 + bj * HALF);
#pragma unroll
            for (int m = 0; m < 4; ++m) {
                const int row = row0 + ai * HALF + m * 16; float ss = 0.f;
#pragma unroll
                for (int bj = 0; bj < 2; ++bj) {
                    u32x4* p = (u32x4*)(xb + (size_t)row * DM + c0 + bj * HALF); const u32x4 s = xs[m][bj];
                    const f32x4 v0 = (f32x4){bf_lo(s.x), bf_hi(s.x), bf_lo(s.y), bf_hi(s.y)} + gv[bj][0] * acc[ai][bj][m][0];
                    const f32x4 v1 = (f32x4){bf_lo(s.z), bf_hi(s.z), bf_lo(s.w), bf_hi(s.w)} + gv[bj][1] * acc[ai][bj][m][1];
                    ss += ((v0[0] * v0[0] + v0[1] * v0[1]) + (v0[2] * v0[2] + v0[3] * v0[3])) + ((v1[0] * v1[0] + v1[1] * v1[1]) + (v1[2] * v1[2] + v1[3] * v1[3]));
                    u32x4 w; w.x = cvt_pk_bf16(v0[0], v0[1]); w.y = cvt_pk_bf16(v0[2], v0[3]); w.z = cvt_pk_bf16(v1[0], v1[1]); w.w = cvt_pk_bf16(v1[2], v1[3]);
                    st16(p, w);
                }
                ss += __shfl_xor(ss, 16); ss += __shfl_xor(ss, 32);
                if (fq == 0) sumsq[(size_t)row * 16 + u.pn * 4 + wc] = ss;
            }
            asm volatile("" ::: "memory");
        }
    }
};
struct EpiGeluV {
    static constexpr bool PERM = true;
    bf16_t* O; const LAS float* bias; const LAS float* rst; float* vsq;
    __device__ __forceinline__ void operator()(const f32x4 (&acc)[2][2][4][2], const Unit& u, int wr, int wc, int fr, int fq) const {
        const int row0 = u.pm * BM + wr * 64 + fr, c0 = u.pn * BM + wc * 32 + 8 * fq;
        f32x4 bv[2][2];
#pragma unroll
        for (int bj = 0; bj < 2; ++bj)
#pragma unroll
            for (int n = 0; n < 2; ++n) bv[bj][n] = *(const LAS f32x4*)(bias + u.idx * 256 + wc * 32 + 8 * fq + bj * HALF + 4 * n);
#pragma unroll
        for (int ai = 0; ai < 2; ++ai)
#pragma unroll
            for (int m = 0; m < 4; ++m) {
                const int row = row0 + ai * HALF + m * 16; const float rs = rst[(u.pm & 7) * 256 + ai * HALF + wr * 64 + m * 16 + fr]; float ss = 0.f;
#pragma unroll
                for (int bj = 0; bj < 2; ++bj) {
                    const f32x4 v0 = gelu4(acc[ai][bj][m][0] * rs + bv[bj][0]), v1 = gelu4(acc[ai][bj][m][1] * rs + bv[bj][1]);
                    ss += ((v0[0] * v0[0] + v0[1] * v0[1]) + (v0[2] * v0[2] + v0[3] * v0[3])) + ((v1[0] * v1[0] + v1[1] * v1[1]) + (v1[2] * v1[2] + v1[3] * v1[3]));
                    u32x4 w; w.x = cvt_pk_bf16(v0[0], v0[1]); w.y = cvt_pk_bf16(v0[2], v0[3]); w.z = cvt_pk_bf16(v1[0], v1[1]); w.w = cvt_pk_bf16(v1[2], v1[3]);
                    st16(O + (size_t)row * GMD + c0 + bj * HALF, w);
                }
                ss += __shfl_xor(ss, 16); ss += __shfl_xor(ss, 32);
                if (fq == 0) vsq[(size_t)row * 48 + u.pn * 4 + wc] = ss;
                asm volatile("" ::: "memory");
            }
    }
};
struct EpiGeluMul {
    static constexpr bool PERM = true;
    bf16_t* SV; const LAS float* bias; const LAS float* rst;
    __device__ __forceinline__ void operator()(const f32x4 (&acc)[2][2][4][2], const Unit& u, int wr, int wc, int fr, int fq) const {
        const int row0 = u.pm * BM + wr * 64 + fr, c0 = u.pn * BM + wc * 32 + 8 * fq;
        f32x4 bv[2][2];
#pragma unroll
        for (int bj = 0; bj < 2; ++bj)
#pragma unroll
            for (int n = 0; n < 2; ++n) bv[bj][n] = *(const LAS f32x4*)(bias + u.idx * 256 + wc * 32 + 8 * fq + bj * HALF + 4 * n);
#pragma unroll
        for (int ai = 0; ai < 2; ++ai) {
            u32x4 xs[4][2];
#pragma unroll
            for (int m = 0; m < 4; ++m)
#pragma unroll
                for (int bj = 0; bj < 2; ++bj) xs[m][bj] = *(const u32x4*)(SV + (size_t)(row0 + ai * HALF + m * 16) * GMD + c0 + bj * HALF);
#pragma unroll
            for (int m = 0; m < 4; ++m) {
                const int row = row0 + ai * HALF + m * 16; const float rs = rst[(u.pm & 7) * 256 + ai * HALF + wr * 64 + m * 16 + fr];
#pragma unroll
                for (int bj = 0; bj < 2; ++bj) {
                    u32x4* p = (u32x4*)(SV + (size_t)row * GMD + c0 + bj * HALF); const u32x4 s = xs[m][bj];
                    const f32x4 v0 = gelu4(acc[ai][bj][m][0] * rs + bv[bj][0]), v1 = gelu4(acc[ai][bj][m][1] * rs + bv[bj][1]);
                    u32x4 w; w.x = cvt_pk_bf16(v0[0] * bf_lo(s.x), v0[1] * bf_hi(s.x)); w.y = cvt_pk_bf16(v0[2] * bf_lo(s.y), v0[3] * bf_hi(s.y));
                    w.z = cvt_pk_bf16(v1[0] * bf_lo(s.z), v1[1] * bf_hi(s.z)); w.w = cvt_pk_bf16(v1[2] * bf_lo(s.w), v1[3] * bf_hi(s.w));
                    st16(p, w);
                }
                asm volatile("" ::: "memory");
            }
        }
    }
};
struct EpiQKV {
    static constexpr bool PERM = true;
    bf16_t* QKV; const LAS float* bias; const LAS float* rst; float* ksum;
    __device__ __forceinline__ void operator()(const f32x4 (&acc)[2][2][4][2], const Unit& u, int wr, int wc, int fr, int fq) const {
        const int which = u.pn >> 2;
        const int row0 = u.pm * BM + wr * 64 + fr, cb = (u.pn & 3) * BM + wc * 32 + 8 * fq;
        bf16_t* base = QKV + (size_t)which * ((size_t)SEQ * DM);
        const float sc = which == 0 ? QSCALE : 1.0f;
        f32x4 bv[2][2], cs[2][2];
#pragma unroll
        for (int bj = 0; bj < 2; ++bj)
#pragma unroll
            for (int n = 0; n < 2; ++n) { bv[bj][n] = *(const LAS f32x4*)(bias + u.idx * 256 + wc * 32 + 8 * fq + bj * HALF + 4 * n); cs[bj][n] = (f32x4){0.f, 0.f, 0.f, 0.f}; }
#pragma unroll
        for (int ai = 0; ai < 2; ++ai)
#pragma unroll
            for (int m = 0; m < 4; ++m) {
                const int row = row0 + ai * HALF + m * 16; const float rs = rst[(u.pm & 7) * 256 + ai * HALF + wr * 64 + m * 16 + fr];
#pragma unroll
                for (int bj = 0; bj < 2; ++bj) {
                    const int c = cb + bj * HALF; const int head = c >> 6, d = c & 63;
                    f32x4 v0 = acc[ai][bj][m][0] * rs + bv[bj][0], v1 = acc[ai][bj][m][1] * rs + bv[bj][1];
                    cs[bj][0] += v0; cs[bj][1] += v1;
                    v0 = v0 * sc; v1 = v1 * sc;
                    u32x4 w; w.x = cvt_pk_bf16(v0[0], v0[1]); w.y = cvt_pk_bf16(v0[2], v0[3]); w.z = cvt_pk_bf16(v1[0], v1[1]); w.w = cvt_pk_bf16(v1[2], v1[3]);
                    st16(base + ((size_t)head * SEQ + row) * HD + d, w);
                }
                asm volatile("" ::: "memory");
            }
        if (which == 1) {
#pragma unroll
            for (int bj = 0; bj < 2; ++bj)
#pragma unroll
                for (int n = 0; n < 2; ++n) {
                    f32x4 s = cs[bj][n];
#pragma unroll
                    for (int o = 1; o < 16; o <<= 1) { s[0] += __shfl_xor(s[0], o); s[1] += __shfl_xor(s[1], o); s[2] += __shfl_xor(s[2], o); s[3] += __shfl_xor(s[3], o); }
                    if (fr == 0) *(f32x4*)(ksum + ((size_t)u.pm * 2 + wr) * DM + cb + bj * HALF + 4 * n) = s;
                }
        }
    }
};
}

struct Args { const float* in[16]; float* out; unsigned char* ws; int ph_lo, ph_hi; };
enum { IN_X = 0, IN_C, IN_RELB, IN_MODW, IN_MODB, IN_NORMG, IN_FWIN, IN_FWOUT, IN_GWIN, IN_GVN, IN_GWS, IN_GBS, IN_GWOUT, IN_WQKV, IN_WO, IN_FNORM };

__device__ __forceinline__ unsigned f2bf(float f) { unsigned u = __builtin_bit_cast(unsigned, f); return (u + 0x7fffu + ((u >> 16) & 1u)) >> 16; }
__device__ __forceinline__ unsigned pk2(float lo, float hi) { return f2bf(lo) | (f2bf(hi) << 16); }
__device__ __forceinline__ void transpose_item(const float* W, int K, int N, bf16_t* WT, int mode, LAS float* scr, int item, int lane, const float* ng = nullptr, const float* sc = nullptr, const float* shift = nullptr, float* bpart = nullptr) {
    const int nblk = N / 32, kb = item / nblk, nb = item % nblk, k0 = 64 * kb, n0 = 32 * nb;
    int r0 = n0;
    if (mode == 1) { const int up = n0 >= DFF ? 1 : 0, f0 = n0 - up * DFF; r0 = (f0 >> 7) * 256 + up * 128 + (f0 & 127); }
    { f32x4 v[8]; const float* wp = W + (size_t)(k0 + (lane >> 3)) * N + n0 + 4 * (lane & 7);
#pragma unroll
      for (int i = 0; i < 8; ++i) v[i] = *(const f32x4*)(wp + (size_t)(8 * i) * N);
      if (bpart) {
          f32x4 ps = (f32x4){0.f, 0.f, 0.f, 0.f};
#pragma unroll
          for (int i = 0; i < 8; ++i) ps += v[i] * shift[k0 + (lane >> 3) + 8 * i];
#pragma unroll
          for (int o = 8; o < 64; o <<= 1) { ps[0] += __shfl_xor(ps[0], o); ps[1] += __shfl_xor(ps[1], o); ps[2] += __shfl_xor(ps[2], o); ps[3] += __shfl_xor(ps[3], o); }
          if (lane < 8) *(f32x4*)(bpart + (size_t)kb * N + n0 + 4 * lane) = ps;
      }
#pragma unroll
      for (int i = 0; i < 8; ++i) { LAS float* d = scr + ((lane >> 3) + 8 * i) * 33 + 4 * (lane & 7); d[0] = v[i][0]; d[1] = v[i][1]; d[2] = v[i][2]; d[3] = v[i][3]; } }
    asm volatile("s_waitcnt lgkmcnt(0)" ::: "memory");
    const int c = lane & 7;
    f32x4 g0 = (f32x4){1.f, 1.f, 1.f, 1.f}, g1 = g0;
    if (ng) { g0 = *(const f32x4*)(ng + k0 + 8 * c) * (*(const f32x4*)(sc + k0 + 8 * c) + 1.0f); g1 = *(const f32x4*)(ng + k0 + 8 * c + 4) * (*(const f32x4*)(sc + k0 + 8 * c + 4) + 1.0f); }
#pragma unroll
    for (int j = 0; j < 4; ++j) { const int n = (lane >> 3) + 8 * j; const LAS float* s = scr + (8 * c) * 33 + n;
        u32x4 o; o.x = pk2(s[0 * 33] * g0[0], s[1 * 33] * g0[1]); o.y = pk2(s[2 * 33] * g0[2], s[3 * 33] * g0[3]); o.z = pk2(s[4 * 33] * g1[0], s[5 * 33] * g1[1]); o.w = pk2(s[6 * 33] * g1[2], s[7 * 33] * g1[3]);
        *(u32x4*)(WT + (size_t)(r0 + n) * K + k0 + 8 * c) = o; }
    asm volatile("s_waitcnt lgkmcnt(0)" ::: "memory");
}
template <bool SILU, int NCOLS>
__device__ __forceinline__ void colsum_item(const float* W, int ldw, int n0, const float* svec, const float* addb, float* out, LAS f32x4* red, int tid) {
    constexpr int NG = NCOLS / 4;
    const int cgp = tid % NG, ks = tid / NG;
    if (ks < 16) {
        f32x4 acc = (f32x4){0.f, 0.f, 0.f, 0.f};
        const float* wp = W + (size_t)(ks * 64) * ldw + n0 + 4 * cgp;
#pragma unroll 16
        for (int kk = 0; kk < 64; ++kk) { float s = svec[ks * 64 + kk]; if (SILU) s = s / (1.0f + __expf(-s)); acc += *(const f32x4*)(wp + (size_t)kk * ldw) * s; }
        red[ks * NG + cgp] = acc;
    }
    __syncthreads();
    if (tid < NG) { f32x4 s = red[tid];
#pragma unroll
        for (int j = 1; j < 16; ++j) s += red[j * NG + tid];
        if (addb) s += *(const f32x4*)(addb + n0 + 4 * tid);
        *(f32x4*)(out + n0 + 4 * tid) = s; }
    __syncthreads();
}

typedef short v4i16_t __attribute__((ext_vector_type(4)));
__device__ __forceinline__ int swap23(int i) { return (i & 0x13) | ((i & 4) << 1) | ((i & 8) >> 1); }
__device__ __forceinline__ void dma_kv(LAS unsigned char* buf, const bf16_t* kblk, const bf16_t* vblk, int tid, int wave) {
#pragma unroll
    for (int i = 0; i < 4; ++i) { const int p = i * 512 + tid, row = p >> 3, c = (p & 7) ^ ((row >> 1) & 7);
        __builtin_amdgcn_global_load_lds((const unsigned*)((const char*)kblk + row * 128 + c * 16), (LAS unsigned*)(buf + i * 8192 + wave * 1024), 16, 0, 0); }
#pragma unroll
    for (int i = 0; i < 4; ++i) { const int p = i * 512 + tid, row = p >> 3, c = (p & 7) ^ (((row >> 1) & 1) << 2);
        __builtin_amdgcn_global_load_lds((const unsigned*)((const char*)vblk + row * 128 + c * 16), (LAS unsigned*)(buf + 32768 + i * 8192 + wave * 1024), 16, 0, 0); }
}
__device__ __forceinline__ float halfmax(float m) {
    const auto rr = __builtin_amdgcn_permlane32_swap(__float_as_uint(m), __float_as_uint(m), false, false);
    return fmaxf(__uint_as_float(rr[0]), __uint_as_float(rr[1]));
}
__device__ __forceinline__ float halfsum(float m) {
    const auto rr = __builtin_amdgcn_permlane32_swap(__float_as_uint(m), __float_as_uint(m), false, false);
    return __uint_as_float(rr[0]) + __uint_as_float(rr[1]);
}
#define MX3(a, b, c) __builtin_fmaxf(__builtin_fmaxf((a), (b)), (c))
template <int MODE>
__device__ __forceinline__ void attn_tile(const bf16x8 (&qf)[4], const LAS unsigned char* kbuf, const LAS unsigned char* vbuf, const LAS float* tabd, int kpos0, int nkt, int tq, int lane,
                                          float& m_out, float& l_out, f32x16 (&o)[2]) {
    const int r32 = lane & 31, hf = lane >> 5;
    const int krow = swap23(r32), kkey = (krow >> 1) & 7;
    const LAS unsigned char* kp = kbuf + krow * 128;
    const int g16 = lane >> 4, q4 = (lane & 15) >> 2, p4 = lane & 3, vkey = ((q4 >> 1) & 1) << 2;
    const LAS unsigned char* vb0 = vbuf + (8 * hf + q4) * 128 + (p4 & 1) * 8;
    const int vc0 = ((2 * (g16 & 1) + (p4 >> 1)) ^ vkey) << 4, vc1 = ((4 + 2 * (g16 & 1) + (p4 >> 1)) ^ vkey) << 4;
    const float b31 = tabd[128];
    float mref = 0.f, l = 0.f;
    f32x16 negc;
#pragma unroll
    for (int r = 0; r < 16; ++r) negc[r] = b31;
    o[0] = (f32x16){}; o[1] = (f32x16){};
#define AT_KS(S, KT) do { bf16x8 kf_[4]; _Pragma("unroll") for (int ds = 0; ds < 4; ++ds) kf_[ds] = *(const LAS bf16x8*)(kp + (KT) * 4096 + (((2 * ds + hf) ^ kkey) << 4)); \
        S = __builtin_amdgcn_mfma_f32_32x32x16_bf16(kf_[0], qf[0], negc, 0, 0, 0); _Pragma("unroll") for (int ds = 1; ds < 4; ++ds) S = __builtin_amdgcn_mfma_f32_32x32x16_bf16(kf_[ds], qf[ds], S, 0, 0, 0); } while (0)
#define AT_FIX(S, KT) do { const int dbase_ = tq - (kpos0 + 32 * (KT) + 8 * hf); if (__any(dbase_ - 23 < 113)) { _Pragma("unroll") for (int r = 0; r < 16; ++r) { const int dist = dbase_ - 16 * (r >> 3) - (r & 7); \
        float v = S[r] + tabd[dist < 0 ? 0 : (dist > 127 ? 127 : dist)]; if (MODE == 1 && dist < 0) v = -1.0e30f; S[r] = v; } } } while (0)
#define AT_PV(S, KT) do { _Pragma("unroll") for (int sx = 0; sx < 2; ++sx) { \
        u32x4 pw; pw.x = cvt_pk_bf16(S[8 * sx + 0], S[8 * sx + 1]); pw.y = cvt_pk_bf16(S[8 * sx + 2], S[8 * sx + 3]); pw.z = cvt_pk_bf16(S[8 * sx + 4], S[8 * sx + 5]); pw.w = cvt_pk_bf16(S[8 * sx + 6], S[8 * sx + 7]); \
        const bf16x8 pb = __builtin_bit_cast(bf16x8, pw); const LAS unsigned char* vr = vb0 + (32 * (KT) + 16 * sx) * 128; \
        const v4i16_t a0 = __builtin_amdgcn_ds_read_tr16_b64_v4i16((LAS v4i16_t*)(vr + vc0)), a1 = __builtin_amdgcn_ds_read_tr16_b64_v4i16((LAS v4i16_t*)(vr + 512 + vc0)); \
        const v4i16_t b0 = __builtin_amdgcn_ds_read_tr16_b64_v4i16((LAS v4i16_t*)(vr + vc1)), b1 = __builtin_amdgcn_ds_read_tr16_b64_v4i16((LAS v4i16_t*)(vr + 512 + vc1)); \
        o[0] = __builtin_amdgcn_mfma_f32_32x32x16_bf16((bf16x8){a0[0], a0[1], a0[2], a0[3], a1[0], a1[1], a1[2], a1[3]}, pb, o[0], 0, 0, 0); \
        o[1] = __builtin_amdgcn_mfma_f32_32x32x16_bf16((bf16x8){b0[0], b0[1], b0[2], b0[3], b1[0], b1[1], b1[2], b1[3]}, pb, o[1], 0, 0, 0); } } while (0)
    for (int kt = 0; kt < nkt; kt += 2) {
        const bool two = kt + 1 < nkt;
        f32x16 s0, s1;
        AT_KS(s0, kt);
        if (two) AT_KS(s1, kt + 1); else {
#pragma unroll
            for (int r = 0; r < 16; ++r) s1[r] = -1.0e30f; }
        AT_FIX(s0, kt);
        if (two) AT_FIX(s1, kt + 1);
        float ma = MX3(s0[0], s0[1], s1[0]), mb = MX3(s0[2], s0[3], s1[1]); ma = MX3(ma, s1[2], s1[3]);
#pragma unroll
        for (int r = 4; r < 16; r += 4) { ma = MX3(ma, s0[r], s0[r + 1]); mb = MX3(mb, s0[r + 2], s0[r + 3]); ma = MX3(ma, s1[r], s1[r + 1]); mb = MX3(mb, s1[r + 2], s1[r + 3]); }
        const float mx = halfmax(fmaxf(ma, mb));
        if (kt == 0 || __any(mx > 8.0f)) {
            const float dl = kt == 0 ? mx : fmaxf(mx, 0.f); mref += dl;
#pragma unroll
            for (int r = 0; r < 16; ++r) { s0[r] -= dl; s1[r] -= dl; negc[r] -= dl; }
            if (kt != 0) { const float f = fast_exp2(-dl); l *= f; o[0] = o[0] * f; o[1] = o[1] * f; }
        }
#pragma unroll
        for (int r = 0; r < 16; ++r) { s0[r] = fast_exp2(s0[r]); s1[r] = fast_exp2(s1[r]); }
        float la = (s0[0] + s0[1]) + (s1[0] + s1[1]), lb = (s0[2] + s0[3]) + (s1[2] + s1[3]);
#pragma unroll
        for (int r = 4; r < 16; r += 4) { la += (s0[r] + s0[r + 1]) + (s1[r] + s1[r + 1]); lb += (s0[r + 2] + s0[r + 3]) + (s1[r + 2] + s1[r + 3]); }
        l += la + lb;
        AT_PV(s0, kt);
        if (two) AT_PV(s1, kt + 1);
    }
#undef AT_KS
#undef AT_FIX
#undef AT_PV
    l = halfsum(l);
    m_out = mref; l_out = l;
}
__device__ __forceinline__ int list_base(int h, int n) { return h * LIST_PER_HEAD + 256 * (63 * n - (n * (n - 1)) / 2); }

#define XB_TMO      128
#define XB_XCNT(j)  (256  + 64 * (j))
#define XB_XSUB(j)  (1280 + 64 * (j))
#define XB_XGEN(j)  (2304 + 64 * (j))
#define XB_TOP      3328
#define XB_TOPGEN   3392
#define XCD_BAR_WORDS 3456
#define XB_SPIN_CAP (1u << 18)
__device__ __forceinline__ unsigned xb_ld(unsigned* p)              { return __hip_atomic_load(p, __ATOMIC_RELAXED, __HIP_MEMORY_SCOPE_AGENT); }
__device__ __forceinline__ unsigned xb_add(unsigned* p, unsigned v) { return __hip_atomic_fetch_add(p, v, __ATOMIC_RELAXED, __HIP_MEMORY_SCOPE_AGENT); }
__device__ __forceinline__ unsigned xb_xcc_id() { return (unsigned)__builtin_amdgcn_s_getreg((3 << 11) | 20) & 0xFu; }
#define XB_SPIN(cond, bar) do { unsigned _sp = 0; while (cond) { __builtin_amdgcn_s_sleep(1); \
    if ((++_sp & 255u) == 0u) { if (xb_ld(&(bar)[XB_TMO])) break; if (_sp > XB_SPIN_CAP) { atomicAdd(&(bar)[XB_TMO], 1u); break; } } } } while (0)
__device__ __forceinline__ void xcd_barrier_complete(unsigned* bar, unsigned x, unsigned& nloc, unsigned& nx) {
    const unsigned G = gridDim.x * gridDim.y * gridDim.z;
    unsigned sum, cnt, mine, sp = 0u;
    for (;;) {
        sum = 0u; cnt = 0u; mine = 0u;
#pragma unroll
        for (unsigned j = 0; j < 16; ++j) { const unsigned c = xb_ld(&bar[XB_XCNT(j)]); sum += c; cnt += (c > 0u) ? 1u : 0u; mine = (j == x) ? c : mine; }
        if (sum == G) break;
        __builtin_amdgcn_s_sleep(1);
        if ((++sp & 255u) == 0u) { if (xb_ld(&bar[XB_TMO])) break; if (sp > XB_SPIN_CAP) { atomicAdd(&bar[XB_TMO], 1u); break; } }
    }
    nloc = mine > 0u ? mine : 1u; nx = cnt > 0u ? cnt : 1u;
}
__device__ __forceinline__ void xcd_barrier(unsigned* bar, volatile LAS unsigned* st) {
    asm volatile("s_waitcnt vmcnt(0)" ::: "memory");
    __syncthreads();
    if (threadIdx.x == 0) {
        __builtin_amdgcn_s_waitcnt(0);
        const unsigned x = st[0]; unsigned nloc = st[2], nx = st[3];
        if (nloc == 0u) { xcd_barrier_complete(bar, x, nloc, nx); st[2] = nloc; st[3] = nx; }
        const unsigned old = xb_add(&bar[XB_XSUB(x)], 1u);
        const unsigned gen = old / nloc;
        if (old + 1u == (gen + 1u) * nloc) {
            __builtin_amdgcn_fence(__ATOMIC_RELEASE, "agent");
            asm volatile("s_waitcnt vmcnt(0)" ::: "memory");
            const unsigned og = xb_add(&bar[XB_TOP], 1u);
            const unsigned tg = og / nx;
            if (og + 1u == (tg + 1u) * nx) xb_add(&bar[XB_TOPGEN], 1u);
            else XB_SPIN(xb_ld(&bar[XB_TOPGEN]) == tg, bar);
            __builtin_amdgcn_fence(__ATOMIC_ACQUIRE, "agent");
            xb_add(&bar[XB_XGEN(x)], 1u);
            asm volatile("s_waitcnt vmcnt(0)" ::: "memory");
        } else {
            XB_SPIN(xb_ld(&bar[XB_XGEN(x)]) == gen, bar);
            __builtin_amdgcn_fence(__ATOMIC_ACQUIRE, "agent");
            asm volatile("s_waitcnt vmcnt(0)" ::: "memory");
        }
    }
    __syncthreads();
}

#define XB2_XSUB(j) (3520 + 64 * (j))
#define XB2_XGEN(j) (4544 + 64 * (j))
__device__ __forceinline__ void xcd_local_barrier(unsigned* bar, volatile LAS unsigned* st) {
    asm volatile("s_waitcnt vmcnt(0)" ::: "memory");
    __syncthreads();
    if (threadIdx.x == 0) {
        __builtin_amdgcn_s_waitcnt(0);
        const unsigned x = st[0], nloc = st[2];
        const unsigned old = xb_add(&bar[XB2_XSUB(x)], 1u);
        const unsigned gen = old / nloc;
        if (old + 1u == (gen + 1u) * nloc) xb_add(&bar[XB2_XGEN(x)], 1u);
        else XB_SPIN(xb_ld(&bar[XB2_XGEN(x)]) == gen, bar);
        __builtin_amdgcn_fence(__ATOMIC_ACQUIRE, "agent");
        asm volatile("s_waitcnt vmcnt(0)" ::: "memory");
    }
    __syncthreads();
}

enum PhaseKind { K_PROA = 0, K_PROB, K_FFNIN, K_RESID, K_GV, K_SPATIAL, K_GU, K_QKV, K_TOPK, K_ATTSEL, K_ATTOWN, K_FINAL };
constexpr int NPHASE = 20;

__device__ __forceinline__ void rstd_prepass(LAS float* rst, const float* sumsq, int g8, int tid) {
    f32x4 v[4][4];
#pragma unroll
    for (int k = 0; k < 4; ++k) { const f32x4* p = (const f32x4*)(sumsq + (size_t)(g8 * 2048 + tid + 512 * k) * 16);
#pragma unroll
        for (int j = 0; j < 4; ++j) v[k][j] = p[j]; }
#pragma unroll
    for (int k = 0; k < 4; ++k) { float s = 0.f;
#pragma unroll
        for (int j = 0; j < 4; ++j) s += (v[k][j].x + v[k][j].y) + (v[k][j].z + v[k][j].w);
        rst[tid + 512 * k] = rsqrtf(s * (1.0f / DM) + RMS_EPS); }
}

__device__ __forceinline__ void bias_prepass(LAS float* bl, const float* bpart, int N, int coloff, bool ffn, const pg8::StaticOrder& S, int tid) {
    const int j = tid & 255, i0 = __builtin_amdgcn_readfirstlane(tid >> 8);
    float v[3][16]; bool ok[3];
#pragma unroll
    for (int q = 0; q < 3; ++q) { pg8::Unit u; ok[q] = S.next(i0 + 2 * q, u);
        const int n = ok[q] ? (ffn ? (j < 128 ? u.pn * 128 + j : DFF + u.pn * 128 + (j - 128)) : coloff + u.pn * 256 + j) : 0;
#pragma unroll
        for (int kb = 0; kb < 16; ++kb) v[q][kb] = bpart[(size_t)kb * N + n]; }
#pragma unroll
    for (int q = 0; q < 3; ++q) { float s = 0.f;
#pragma unroll
        for (int kb = 0; kb < 16; ++kb) s += v[q][kb];
        if (ok[q]) bl[(i0 + 2 * q) * 256 + j] = s; }
    __syncthreads();
}

__device__ __forceinline__ void phase_proa(const Args& args, unsigned char* ws, LAS unsigned char* lds, int tid, int lane, int wave, int G, int bx, int vcu) {
    float* mod = (float*)(ws + WS_MOD);
    LAS f32x4* red = (LAS f32x4*)lds;
    for (int it = bx; it < 256; it += G) {
        const int layer = it / 128, n0 = (it % 128) * 72;
        colsum_item<true, 72>(args.in[IN_MODW] + (size_t)layer * DM * 9216, 9216, n0, args.in[IN_C], args.in[IN_MODB] + layer * 9216, mod + layer * 9216, red, tid);
    }
    __syncthreads();
    LAS float* scr = (LAS float*)(lds + wave * 16384);
    const int gw = vcu * NWAVES + wave, NGW = G * NWAVES;
    constexpr int I_FOUT = (DFF / 64) * (DM / 32), I_GOUT = (GMD / 64) * (DM / 32);
    constexpr int NITEMS = I_FOUT + I_GOUT;
    for (int it = gw; it < NITEMS; it += NGW) {
        int r = it;
        if (r < I_FOUT) { transpose_item(args.in[IN_FWOUT], DFF, DM, (bf16_t*)(ws + W0_FOUT), 0, scr, r, lane); continue; }
        r -= I_FOUT;
        transpose_item(args.in[IN_GWOUT], GMD, DM, (bf16_t*)(ws + W0_GOUT), 0, scr, r, lane);
    }
}
__device__ __forceinline__ void deferred_convert(const Args& args, unsigned char* ws, LAS unsigned char* lds, int lane, int wave, int rank, int nidle, int stage) {
    const float* mod = (const float*)(ws + WS_MOD); const float* ngp = args.in[IN_NORMG]; float* bpart = (float*)(ws + WS_BPART);
    LAS float* scr = (LAS float*)(lds + wave * 16384);
    const int gw = rank * NWAVES + wave, NGW = nidle * NWAVES;
    constexpr int I_FIN = (DM / 64) * (NFF2 / 32), I_FOUT = (DFF / 64) * (DM / 32), I_QKV = (DM / 64) * (3072 / 32), I_WO = (DM / 64) * (DM / 32);
    const int w = 2 + stage, sub = stage ? 2 : 0;
    const int nitems = I_FIN + I_FOUT + (stage == 0 ? I_FIN + I_FOUT : I_QKV + I_WO);
    for (int it = gw; it < nitems; it += NGW) {
        int r = it;
        if (r < I_FIN) { transpose_item(args.in[IN_FWIN] + (size_t)w * DM * NFF2, DM, NFF2, (bf16_t*)(ws + W1_FIN + (size_t)stage * SZ_FIN), 1, scr, r, lane, ngp + (3 + sub) * DM, mod + 9216 + (sub * 3 + 1) * DM, mod + 9216 + (sub * 3 + 0) * DM, bpart + BP_F + w * 16 * NFF2); continue; }
        r -= I_FIN;
        if (r < I_FOUT) { transpose_item(args.in[IN_FWOUT] + (size_t)w * DFF * DM, DFF, DM, (bf16_t*)(ws + W1_FOUT + (size_t)stage * SZ_FOUT), 0, scr, r, lane); continue; }
        r -= I_FOUT;
        if (stage == 0) {
            if (r < I_FIN) { transpose_item(args.in[IN_FWIN] + (size_t)1 * DM * NFF2, DM, NFF2, (bf16_t*)(ws + W0_FIN + SZ_FIN), 1, scr, r, lane, ngp + 2 * DM, mod + (2 * 3 + 1) * DM, mod + (2 * 3 + 0) * DM, bpart + BP_F + 1 * 16 * NFF2); continue; }
            r -= I_FIN;
            transpose_item(args.in[IN_FWOUT] + (size_t)1 * DFF * DM, DFF, DM, (bf16_t*)(ws + W0_FOUT + SZ_FOUT), 0, scr, r, lane);
        } else {
            if (r < I_QKV) { transpose_item(args.in[IN_WQKV], DM, 3072, (bf16_t*)(ws + W1_QKV), 0, scr, r, lane, ngp + (3 + 1) * DM, mod + 9216 + (1 * 3 + 1) * DM, mod + 9216 + (1 * 3 + 0) * DM, bpart + BP_Q); continue; }
            r -= I_QKV;
            transpose_item(args.in[IN_WO], DM, DM, (bf16_t*)(ws + W1_WO), 0, scr, r, lane);
        }
    }
}

__device__ __forceinline__ void phase_prob(const Args& args, unsigned char* ws, LAS unsigned char* lds, int tid, int lane, int wave, int G, int bx, int vcu) {
    float* mod = (float*)(ws + WS_MOD);
    float* bpart = (float*)(ws + WS_BPART);
    float* tab = (float*)(ws + WS_TAB); float* sumsq = (float*)(ws + WS_SUMSQ); bf16_t* xb = (bf16_t*)(ws + WS_XB);
    const int gt = bx * NTHREADS + tid, NT = G * NTHREADS;
    for (int i = gt; i < 6 * DM; i += NT) { const int ls = i / DM, k = i % DM, layer = ls / 3, sub = ls % 3;
        ((float*)(ws + WS_GATE))[i] = mod[layer * 9216 + (sub * 3 + 2) * DM + k] * (sub == 1 ? 1.0f : 0.5f); }
    for (int i = gt; i < NH * 128; i += NT) { const int h = i >> 7, n = i & 127; int b;
        if (n < 16) b = n; else { b = 16 + (int)(logf((float)n / 16.0f) / 2.0794415416798357f * 16.0f); b = b > 31 ? 31 : b; }
        tab[i] = args.in[IN_RELB][b * NH + h] * LOG2E; }
    const int gw = vcu * NWAVES + wave, NGW = G * NWAVES;
    {
        LAS float* scr = (LAS float*)(lds + wave * 16384);
        const float* ngp = args.in[IN_NORMG];
        constexpr int I_FIN = (DM / 64) * (NFF2 / 32), I_GIN = (DM / 64) * (6144 / 32);
        constexpr int NITEMS = I_FIN + I_GIN;
        for (int it = gw; it < NITEMS; it += NGW) {
            int r = it;
            if (r < I_FIN) { transpose_item(args.in[IN_FWIN], DM, NFF2, (bf16_t*)(ws + W0_FIN), 1, scr, r, lane, ngp, mod + (0 * 3 + 1) * DM, mod + (0 * 3 + 0) * DM, bpart + BP_F); continue; }
            r -= I_FIN;
            transpose_item(args.in[IN_GWIN], DM, 6144, (bf16_t*)(ws + W0_GIN), 0, scr, r, lane, ngp + (0 * 3 + 1) * DM, mod + 0 * 9216 + (1 * 3 + 1) * DM, mod + 0 * 9216 + (1 * 3 + 0) * DM, bpart + BP_G);
        }
    }
    const float* x = args.in[IN_X];
    for (int m0 = gw * 4; m0 < SEQ; m0 += NGW * 4) {
        f32x4 v[4][4];
#pragma unroll
        for (int r = 0; r < 4; ++r) { const f32x4* xr = (const f32x4*)(x + (size_t)(m0 + r) * DM) + lane;
#pragma unroll
            for (int j = 0; j < 4; ++j) v[r][j] = xr[64 * j]; }
#pragma unroll
        for (int r = 0; r < 4; ++r) { float s = 0.f;
#pragma unroll
            for (int j = 0; j < 4; ++j) s += (v[r][j].x * v[r][j].x + v[r][j].y * v[r][j].y) + (v[r][j].z * v[r][j].z + v[r][j].w * v[r][j].w);
            s = wave_sum(s);
            u32x2* o8 = (u32x2*)(xb + (size_t)(m0 + r) * DM) + lane;
#pragma unroll
            for (int j = 0; j < 4; ++j) { u32x2 w; w.x = cvt_pk_bf16(v[r][j].x, v[r][j].y); w.y = cvt_pk_bf16(v[r][j].z, v[r][j].w); o8[64 * j] = w; }
            if (lane < 16) sumsq[(size_t)(m0 + r) * 16 + lane] = lane == 0 ? s : 0.f; }
    }
}

__device__ __forceinline__ void phase_spatial(const Args& args, unsigned char* ws, LAS unsigned char* lds, int tid, int lane, int wave, int G, int vcu, bool nostore) {
    const float* vsq = (const float*)(ws + WS_VSQ); bf16_t* zv = (bf16_t*)(ws + WS_ZV);
    const float* wsp = args.in[IN_GWS]; const float* bsp = args.in[IN_GBS]; const float* vnp = args.in[IN_GVN];
    LAS float* rsd = (LAS float*)lds;
    LAS unsigned char* Wimg = lds + 1024;
    LAS unsigned char* Vimg = lds + 36864;
    constexpr int VST = 72, VSL = 128 * VST;
    const int nit_sp = (G == 256) ? 8 : (128 * 16 + G - 1 - vcu) / G;
#define SP_ITEM(K) ((G == 256) ? (vcu >> 5) * 256 + (vcu & 31) + 32 * (K) : vcu + (K) * G)
#define SP_LOAD(V, RS, IT) do { const int c_ = (IT) >> 4, g_ = (IT) & 15; \
        _Pragma("unroll") for (int i = 0; i < 6; ++i) { const int cidx = tid + 512 * i, row = cidx / 24, ch = cidx % 24; V[i] = *(const u32x4*)(zv + (size_t)(c_ * 128 + row) * GMD + g_ * 192 + ch * 8); } \
        if (tid < 128) { const f32x4* pp = (const f32x4*)(vsq + (size_t)(c_ * 128 + tid) * 48); float s = 0.f; \
            _Pragma("unroll") for (int j = 0; j < 12; ++j) { const f32x4 a = pp[j]; s += (a.x + a.y) + (a.z + a.w); } RS = rsqrtf(s * (1.0f / GMD) + RMS_EPS); } } while (0)
    u32x4 vcur[6]; float rs_cur = 0.f; f32x4 wreg[4][2]; int g_loaded = -1;
    if (nit_sp > 0) SP_LOAD(vcur, rs_cur, SP_ITEM(0));
    for (int k_sp = 0; k_sp < nit_sp; ++k_sp) {
        const int it = SP_ITEM(k_sp);
        const int c = it >> 4, g = it & 15;
        __syncthreads();
        if (tid < 128) rsd[tid] = rs_cur;
#pragma unroll
        for (int i = 0; i < 6; ++i) { const int cidx = tid + 512 * i, row = cidx / 24, ch = cidx % 24, w = ch >> 2, c4 = ch & 3;
            LAS u32x2* d = (LAS u32x2*)(Vimg + w * VSL + row * VST + c4 * 16); d[0] = (u32x2){vcur[i].x, vcur[i].y}; d[1] = (u32x2){vcur[i].z, vcur[i].w}; }
        u32x4 vnext[6]; float rs_next = 0.f;
        if (k_sp + 1 < nit_sp) SP_LOAD(vnext, rs_next, SP_ITEM(k_sp + 1));
        else {
#pragma unroll
            for (int i = 0; i < 6; ++i) vnext[i] = vcur[i]; }
        __syncthreads();
        if (g != g_loaded) {
#pragma unroll
            for (int i = 0; i < 4; ++i) { const int cidx = tid + 512 * i, t = cidx >> 4, s0 = (cidx & 15) * 8; const float* wrow = wsp + ((size_t)g * 128 + t) * 128 + s0;
                wreg[i][0] = *(const f32x4*)wrow; wreg[i][1] = *(const f32x4*)(wrow + 4); }
            g_loaded = g;
        }
#pragma unroll
        for (int i = 0; i < 4; ++i) { const int cidx = tid + 512 * i, t = cidx >> 4, s0 = (cidx & 15) * 8;
            const f32x4 w0 = wreg[i][0], w1 = wreg[i][1];
            float a[8];
#pragma unroll
            for (int j = 0; j < 4; ++j) { a[j] = (s0 + j <= t) ? w0[j] * rsd[s0 + j] : 0.f; a[4 + j] = (s0 + 4 + j <= t) ? w1[j] * rsd[s0 + 4 + j] : 0.f; }
            u32x4 aw; aw.x = cvt_pk_bf16(a[0], a[1]); aw.y = cvt_pk_bf16(a[2], a[3]); aw.z = cvt_pk_bf16(a[4], a[5]); aw.w = cvt_pk_bf16(a[6], a[7]);
            *(LAS u32x4*)(Wimg + t * 272 + s0 * 2) = aw; }
        __syncthreads();
        if (wave < 6) {
            const int r32 = lane & 31, hf = lane >> 5, g16 = lane >> 4, i16 = lane & 15, q = i16 >> 2, pp = i16 & 3;
            LAS unsigned char* slice = Vimg + wave * VSL;
            const LAS unsigned char* vb = slice + (8 * hf + q) * VST + (16 * (g16 & 1) + 4 * pp) * 2;
            bf16x8 af[8];
#pragma unroll
            for (int ks = 0; ks < 8; ++ks) {
                const v4i16_t lo = __builtin_amdgcn_ds_read_tr16_b64_v4i16((LAS v4i16_t*)(vb + ks * 16 * VST));
                const v4i16_t hi = __builtin_amdgcn_ds_read_tr16_b64_v4i16((LAS v4i16_t*)(vb + ks * 16 * VST + 4 * VST));
                af[ks] = (bf16x8){lo[0], lo[1], lo[2], lo[3], hi[0], hi[1], hi[2], hi[3]};
            }
            f32x16 acc[4];
#pragma unroll
            for (int i = 0; i < 4; ++i) {
                acc[i] = (f32x16){};
                const LAS unsigned char* wr_ = Wimg + (32 * i + r32) * 272 + 16 * hf;
#pragma unroll
                for (int ks = 0; ks < 2 * i + 2; ++ks) {
                    const bf16x8 bfrag = *(const LAS bf16x8*)(wr_ + 32 * ks);
                    acc[i] = __builtin_amdgcn_mfma_f32_32x32x16_bf16(af[ks], bfrag, acc[i], 0, 0, 0);
                }
            }
            f32x4 vn4[4];
#pragma unroll
            for (int g4 = 0; g4 < 4; ++g4) vn4[g4] = *(const f32x4*)(vnp + g * 192 + wave * 32 + 8 * g4 + 4 * hf);
#pragma unroll
            for (int i = 0; i < 4; ++i) {
                const float bsv = bsp[g * 128 + 32 * i + r32];
#pragma unroll
                for (int g4 = 0; g4 < 4; ++g4) {
                    const float v0 = acc[i][4 * g4] * vn4[g4][0] + bsv, v1 = acc[i][4 * g4 + 1] * vn4[g4][1] + bsv, v2 = acc[i][4 * g4 + 2] * vn4[g4][2] + bsv, v3 = acc[i][4 * g4 + 3] * vn4[g4][3] + bsv;
                    u32x2 w; w.x = cvt_pk_bf16(v0, v1); w.y = cvt_pk_bf16(v2, v3);
                    *(LAS u32x2*)(slice + (32 * i + r32) * VST + (8 * g4 + 4 * hf) * 2) = w;
                }
            }
        }
        __syncthreads();
#pragma unroll
        for (int i = 0; i < 6; ++i) { const int cidx = tid + 512 * i, row = cidx / 24, ch = cidx % 24, w = ch >> 2, c4 = ch & 3;
            const LAS u32x2* d = (const LAS u32x2*)(Vimg + w * VSL + row * VST + c4 * 16); const u32x2 a = d[0], b = d[1];
            if (!nostore) st16(zv + (size_t)(c * 128 + row) * GMD + g * 192 + ch * 8, (u32x4){a.x, a.y, b.x, b.y}); }
#pragma unroll
        for (int i = 0; i < 6; ++i) vcur[i] = vnext[i];
        rs_cur = rs_next;
    }
#undef SP_ITEM
#undef SP_LOAD
}

__device__ __forceinline__ void phase_topk(unsigned char* ws, LAS unsigned char* lds, int tid, int lane, int wave, int G, int vcu, bool nostore) {
    const float* ksum = (const float*)(ws + WS_KSUM); unsigned* cnt = (unsigned*)(ws + WS_CTL);
    unsigned short* lists = (unsigned short*)(ws + AT_LIST); const bf16_t* qh = (const bf16_t*)(ws + AT_Q);
    LAS unsigned* lcnt = (LAS unsigned*)lds;
    LAS unsigned* lbase = (LAS unsigned*)(lds + 1024);
    const int r32 = lane & 31, hf = lane >> 5;
    const int nper = (NH * 64 + G - 1) / G;
    bf16x8 khi[2][4], klo[2][4]; int h_loaded = -1;
    for (int kb = 0; kb < nper; kb += 4) {
        __syncthreads();
        if (tid < 256) lcnt[tid] = 0u;
        __syncthreads();
        int pi0[4], pi1[4], pi2[4], pt[4], pns[4], phh[4]; unsigned prk0[4], prk1[4], prk2[4];
#pragma unroll
        for (int j = 0; j < 4; ++j) {
            const int it = vcu * nper + kb + j; const bool on = kb + j < nper && it < NH * 64 && (it & 63) != 0;
            const int h = it >> 6, jb = it & 63;
            pns[j] = 0; phh[j] = on ? h : 0; pi0[j] = 0; pi1[j] = 0; pi2[j] = 0; pt[j] = 0; prk0[j] = 0u; prk1[j] = 0u; prk2[j] = 0u;
            if (on) {
                if (h != h_loaded) {
#pragma unroll
                    for (int nt = 0; nt < 2; ++nt) {
                        const float* k0 = ksum + ((size_t)(32 * nt + r32) * 2) * DM + h * HD + 8 * hf;
#pragma unroll
                        for (int ds = 0; ds < 4; ++ds) {
                            const f32x4 a0 = *(const f32x4*)(k0 + 16 * ds), a1 = *(const f32x4*)(k0 + 16 * ds + 4), b0 = *(const f32x4*)(k0 + DM + 16 * ds), b1 = *(const f32x4*)(k0 + DM + 16 * ds + 4);
                            const f32x4 x0 = a0 + b0, x1 = a1 + b1;
                            u32x4 hi; hi.x = cvt_pk_bf16(x0[0], x0[1]); hi.y = cvt_pk_bf16(x0[2], x0[3]); hi.z = cvt_pk_bf16(x1[0], x1[1]); hi.w = cvt_pk_bf16(x1[2], x1[3]);
                            u32x4 lo; lo.x = cvt_pk_bf16(x0[0] - bf_lo(hi.x), x0[1] - bf_hi(hi.x)); lo.y = cvt_pk_bf16(x0[2] - bf_lo(hi.y), x0[3] - bf_hi(hi.y));
                            lo.z = cvt_pk_bf16(x1[0] - bf_lo(hi.z), x1[1] - bf_hi(hi.z)); lo.w = cvt_pk_bf16(x1[2] - bf_lo(hi.w), x1[3] - bf_hi(hi.w));
                            khi[nt][ds] = __builtin_bit_cast(bf16x8, hi); klo[nt][ds] = __builtin_bit_cast(bf16x8, lo);
                        }
                    }
                    h_loaded = h;
                }
                const int t = jb * 256 + wave * 32 + r32;
                bf16x8 qf[4];
#pragma unroll
                for (int ds = 0; ds < 4; ++ds) qf[ds] = *(const bf16x8*)(qh + ((size_t)h * SEQ + t) * HD + 16 * ds + 8 * hf);
                f32x16 sc[2];
#pragma unroll
                for (int nt = 0; nt < 2; ++nt) {
                    sc[nt] = (f32x16){};
                    if (32 * nt < jb) {
#pragma unroll
                        for (int ds = 0; ds < 4; ++ds) {
                            sc[nt] = __builtin_amdgcn_mfma_f32_32x32x16_bf16(khi[nt][ds], qf[ds], sc[nt], 0, 0, 0);
                            sc[nt] = __builtin_amdgcn_mfma_f32_32x32x16_bf16(klo[nt][ds], qf[ds], sc[nt], 0, 0, 0);
                        }
                    }
                }
                int ka = (int)0x80000000, kb_ = (int)0x80000000, kc = (int)0x80000000;
#define TK_INS(X) do { const int x_ = (X); const int t1_ = x_ < ka ? x_ : ka; ka = x_ > ka ? x_ : ka; const int t2_ = t1_ < kb_ ? t1_ : kb_; kb_ = t1_ > kb_ ? t1_ : kb_; kc = t2_ > kc ? t2_ : kc; } while (0)
#pragma unroll
                for (int nt = 0; nt < 2; ++nt)
#pragma unroll
                    for (int r = 0; r < 16; ++r) {
                        const int n = 32 * nt + (r & 3) + 8 * (r >> 2) + 4 * hf;
                        const int bits = __float_as_int(sc[nt][r]); const int mono = bits ^ (int)((unsigned)(bits >> 31) >> 1);
                        const int key = n < jb ? ((mono & ~63) | (63 - n)) : (int)0x80000000;
                        TK_INS(key);
                    }
                { const int pa = __shfl_xor(ka, 32), pb2 = __shfl_xor(kb_, 32), pc = __shfl_xor(kc, 32); TK_INS(pa); TK_INS(pb2); TK_INS(pc); }
#undef TK_INS
                const int i0 = 63 - (ka & 63), i1 = 63 - (kb_ & 63), i2 = 63 - (kc & 63);
                const int nsel = jb < 3 ? jb : 3; const bool act = hf == 0;
                LAS unsigned* lc = lcnt + j * 64;
                if (act && nsel > 0) prk0[j] = atomicAdd((unsigned*)&lc[i0], 1u);
                if (act && nsel > 1) prk1[j] = atomicAdd((unsigned*)&lc[i1], 1u);
                if (act && nsel > 2) prk2[j] = atomicAdd((unsigned*)&lc[i2], 1u);
                pns[j] = act ? nsel : 0; pi0[j] = i0; pi1[j] = i1; pi2[j] = i2; pt[j] = t;
            }
        }
        __syncthreads();
        if (tid < 256) { const int j = tid >> 6, n = tid & 63; const int hj = j == 0 ? phh[0] : (j == 1 ? phh[1] : (j == 2 ? phh[2] : phh[3]));
            const unsigned cc = lcnt[tid]; lbase[tid] = (cc && !nostore) ? atomicAdd(&cnt[hj * 64 + n], cc) : 0u; }
        __syncthreads();
        if (!nostore) {
#pragma unroll
            for (int j = 0; j < 4; ++j) { const LAS unsigned* lb = lbase + j * 64;
                if (pns[j] > 0) lists[list_base(phh[j], pi0[j]) + lb[pi0[j]] + prk0[j]] = (unsigned short)((pt[j] << 2) | 0);
                if (pns[j] > 1) lists[list_base(phh[j], pi1[j]) + lb[pi1[j]] + prk1[j]] = (unsigned short)((pt[j] << 2) | 1);
                if (pns[j] > 2) lists[list_base(phh[j], pi2[j]) + lb[pi2[j]] + prk2[j]] = (unsigned short)((pt[j] << 2) | 2); }
        }
    }
}

__device__ __forceinline__ void attsel_locate(const LAS unsigned* pre, int item, int& li, int& ci) {
    int lo = 0, hi = 1023;
    while (lo < hi) { const int mid = (lo + hi + 1) >> 1; if ((int)pre[mid] <= item) lo = mid; else hi = mid - 1; }
    li = lo; ci = item - (int)pre[lo];
}
__device__ __forceinline__ void load_q4(bf16x8 (&qf)[4], const bf16_t* qrow, int hf) {
#pragma unroll
    for (int ds = 0; ds < 4; ++ds) qf[ds] = *(const bf16x8*)(qrow + 16 * ds + 8 * hf);
}
__device__ __forceinline__ void phase_attsel(unsigned char* ws, LAS unsigned char* lds, int tid, int lane, int wave, int G, int vcu, bool dup) {
    const unsigned* cnt = (const unsigned*)(ws + WS_CTL); const float* tab = (const float*)(ws + WS_TAB);
    const unsigned short* lists = (const unsigned short*)(ws + AT_LIST); f32x2* pml = (f32x2*)(ws + AT_ML);
    const bf16_t* qh = (const bf16_t*)(ws + AT_Q); const bf16_t* kh = (const bf16_t*)(ws + AT_K); const bf16_t* vh = (const bf16_t*)(ws + AT_V); bf16_t* po = (bf16_t*)(ws + AT_PO);
    LAS unsigned* pre = (LAS unsigned*)(lds + RING_BYTES);
    LAS unsigned short* cn16 = (LAS unsigned short*)(lds + RING_BYTES + 4224);
    LAS float* tabl = (LAS float*)(lds + RING_BYTES + 8448);
    __syncthreads();
    for (int i = tid; i < 1024; i += NTHREADS) { const unsigned c = cnt[i]; pre[i + 1] = (c + 255u) >> 8; cn16[i] = (unsigned short)c; }
    if (tid == 0) pre[0] = 0u;
    __syncthreads();
    if (tid < 64) {
        unsigned v[16]; unsigned s = 0;
#pragma unroll
        for (int i = 0; i < 16; ++i) { v[i] = pre[1 + tid * 16 + i]; s += v[i]; }
        unsigned inc = s;
#pragma unroll
        for (int o = 1; o < 64; o <<= 1) { const unsigned y = __shfl_up(inc, o); if (lane >= o) inc += y; }
        unsigned run = inc - s;
#pragma unroll
        for (int i = 0; i < 16; ++i) { run += v[i]; pre[1 + tid * 16 + i] = run; }
    }
    __syncthreads();
    const int total = (int)pre[1024];
    const int r32 = lane & 31, hf = lane >> 5;
    const int q_per = (total + G - 1) / G, g0 = vcu * q_per, g1 = (g0 + q_per < total) ? g0 + q_per : total;
    if (g0 >= g1) return;
    int g = g0, li = 0, ci = 0, b = 0;
    bool have_pre = false; unsigned pre_e0 = 0u, pre_e1 = 0u; bf16x8 pre_q[4] = {};
    attsel_locate(pre, g, li, ci);
    { const int h = li >> 6, n = li & 63;
      if (tid < 129) tabl[tid] = tid < 128 ? tab[h * 128 + tid] - tab[h * 128 + 127] : tab[h * 128 + 127];
      dma_kv(lds, kh + ((size_t)h * SEQ + n * 256) * HD, vh + ((size_t)h * SEQ + n * 256) * HD, tid, wave); }
#define ATS_ENTRY(CI) lists[lbase_ + ((CI) * 256 + wave * 32 + r32 < cn ? (CI) * 256 + wave * 32 + r32 : (CI) * 256 + wave * 32)]
    while (g < g1) {
        const int h = li >> 6, n = li & 63, cn = (int)cn16[li];
        const int c0 = g - (int)pre[li], nch = (int)pre[li + 1] - (int)pre[li], c1 = (c0 + (g1 - g) < nch) ? c0 + (g1 - g) : nch;
        const int gn = g + (c1 - c0); int lin = li + 1;
        if (gn < g1) { while (lin < 1023 && pre[lin + 1] == pre[lin]) ++lin;
            const int h2 = lin >> 6, n2 = lin & 63;
            if (tid < 129) tabl[(b ^ 1) * 132 + tid] = tid < 128 ? tab[h2 * 128 + tid] - tab[h2 * 128 + 127] : tab[h2 * 128 + 127];
            dma_kv(lds + (b ^ 1) * 65536, kh + ((size_t)h2 * SEQ + n2 * 256) * HD, vh + ((size_t)h2 * SEQ + n2 * 256) * HD, tid, wave);
            asm volatile("s_waitcnt vmcnt(8)" ::: "memory"); }
        else asm volatile("s_waitcnt vmcnt(0)" ::: "memory");
        asm volatile("s_waitcnt lgkmcnt(0)" ::: "memory"); __builtin_amdgcn_s_barrier(); asm volatile("" ::: "memory");
        const int lbase_ = list_base(h, n);
        if (c0 * 256 + wave * 32 < cn) {
            unsigned e_cur, e_nxt = 0u; bf16x8 qf[4];
            if (have_pre) { e_cur = pre_e0; e_nxt = pre_e1;
#pragma unroll
                for (int ds = 0; ds < 4; ++ds) qf[ds] = pre_q[ds]; }
            else { e_cur = ATS_ENTRY(c0);
                if (c0 + 1 < c1 && (c0 + 1) * 256 + wave * 32 < cn) e_nxt = ATS_ENTRY(c0 + 1);
                load_q4(qf, qh + ((size_t)h * SEQ + (e_cur >> 2)) * HD, hf); }
            for (int c = c0; c < c1; ++c) {
                const int e0 = c * 256 + wave * 32;
                if (e0 >= cn) break;
                const bool has1 = c + 1 < c1 && e0 + 256 < cn, has2 = c + 2 < c1 && e0 + 512 < cn;
                unsigned e_n2 = 0u; bf16x8 qn[4] = {};
                if (has2) e_n2 = ATS_ENTRY(c + 2);
                if (has1) load_q4(qn, qh + ((size_t)h * SEQ + (e_nxt >> 2)) * HD, hf);
                const bool valid = e0 + r32 < cn; const int t = (int)(e_cur >> 2), slot = (int)(e_cur & 3u);
                float m, l; f32x16 o[2];
                if (!(dup && (PROBE_ATT & 1))) attn_tile<0>(qf, lds + b * 65536, lds + b * 65536 + 32768, tabl + b * 132, n * 256, 8, t, lane, m, l, o); else { m = 0.f; l = 1.f; o[0] = (f32x16){}; o[1] = (f32x16){}; }
                if (valid && !(dup && (PROBE_ATT & 2))) {
                    const float inv = fast_rcp(l); const size_t pe = ((size_t)h * SEQ + t) * 3 + slot;
                    bf16_t* op = po + pe * HD + 32 * hf;
#pragma unroll
                    for (int dt = 0; dt < 2; ++dt)
#pragma unroll
                        for (int gp = 0; gp < 2; ++gp) { u32x4 w; w.x = cvt_pk_bf16(o[dt][8 * gp] * inv, o[dt][8 * gp + 1] * inv); w.y = cvt_pk_bf16(o[dt][8 * gp + 2] * inv, o[dt][8 * gp + 3] * inv);
                            w.z = cvt_pk_bf16(o[dt][8 * gp + 4] * inv, o[dt][8 * gp + 5] * inv); w.w = cvt_pk_bf16(o[dt][8 * gp + 6] * inv, o[dt][8 * gp + 7] * inv);
                            st16(op + 16 * dt + 8 * gp, w); }
                    if (hf == 0) pml[pe] = (f32x2){m, l};
                }
                e_cur = e_nxt; e_nxt = e_n2;
#pragma unroll
                for (int ds = 0; ds < 4; ++ds) qf[ds] = qn[ds];
            }
        }
        have_pre = false;
        if (gn < g1) { const int h2 = lin >> 6, n2 = lin & 63, cn2 = (int)cn16[lin], lb2 = list_base(h2, n2), nch2 = (int)pre[lin + 1] - (int)pre[lin], c12 = (g1 - gn < nch2) ? g1 - gn : nch2;
            if (wave * 32 < cn2) { have_pre = true;
                pre_e0 = lists[lb2 + (wave * 32 + r32 < cn2 ? wave * 32 + r32 : wave * 32)]; pre_e1 = 0u;
                if (1 < c12 && 256 + wave * 32 < cn2) pre_e1 = lists[lb2 + (256 + wave * 32 + r32 < cn2 ? 256 + wave * 32 + r32 : 256 + wave * 32)];
                load_q4(pre_q, qh + ((size_t)h2 * SEQ + (pre_e0 >> 2)) * HD, hf); } }
        asm volatile("s_waitcnt lgkmcnt(0)" ::: "memory"); __builtin_amdgcn_s_barrier(); asm volatile("" ::: "memory");
        g = gn; li = lin; b ^= 1;
    }
#undef ATS_ENTRY
}

__device__ __forceinline__ void phase_attown(unsigned char* ws, LAS unsigned char* lds, int tid, int lane, int wave, int G, int vcu, bool nostore) {
    const float* tab = (const float*)(ws + WS_TAB); const f32x2* pml = (const f32x2*)(ws + AT_ML);
    bf16_t* qh = (bf16_t*)(ws + AT_Q); const bf16_t* kh = (const bf16_t*)(ws + AT_K); const bf16_t* vh = (const bf16_t*)(ws + AT_V); const bf16_t* po = (const bf16_t*)(ws + AT_PO);
    LAS float* tabl = (LAS float*)(lds + RING_BYTES + 8448);
    const int sub = wave < 4 ? wave : 11 - wave;
    const int r32 = lane & 31, hf = lane >> 5;
    int it = vcu, b = 0; bf16x8 qf[4] = {};
    __syncthreads();
    if (it < NH * 64) { if (tid < 129) tabl[tid] = tid < 128 ? tab[(it >> 6) * 128 + tid] - tab[(it >> 6) * 128 + 127] : tab[(it >> 6) * 128 + 127];
        load_q4(qf, qh + ((size_t)it * 256 + sub * 32 + r32) * HD, hf);
        dma_kv(lds, kh + (size_t)it * 256 * HD, vh + (size_t)it * 256 * HD, tid, wave); }
    for (; it < NH * 64; it += G) {
        const int nit = it + G;
        if (nit < NH * 64) { if (tid < 129) tabl[(b ^ 1) * 132 + tid] = tid < 128 ? tab[(nit >> 6) * 128 + tid] - tab[(nit >> 6) * 128 + 127] : tab[(nit >> 6) * 128 + 127];
            dma_kv(lds + (b ^ 1) * 65536, kh + (size_t)nit * 256 * HD, vh + (size_t)nit * 256 * HD, tid, wave); asm volatile("s_waitcnt vmcnt(8)" ::: "memory"); }
        else asm volatile("s_waitcnt vmcnt(0)" ::: "memory");
        asm volatile("s_waitcnt lgkmcnt(0)" ::: "memory"); __builtin_amdgcn_s_barrier(); asm volatile("" ::: "memory");
        bf16x8 qn[4] = {};
        if (nit < NH * 64) load_q4(qn, qh + ((size_t)nit * 256 + sub * 32 + r32) * HD, hf);
        const int h = it >> 6, j = it & 63;
        const int t = j * 256 + sub * 32 + r32;
        float m, l; f32x16 o[2];
        if (!(nostore && (PROBE_ATT & 1))) attn_tile<1>(qf, lds + b * 65536, lds + b * 65536 + 32768, tabl + b * 132, j * 256, sub + 1, t, lane, m, l, o); else { m = 0.f; l = 1.f; o[0] = (f32x16){}; o[1] = (f32x16){}; }
        const int nsel = (nostore && (PROBE_ATT & 2)) ? 0 : (j < 3 ? j : 3); const size_t pe = ((size_t)h * SEQ + t) * 3;
        float pm[3], pl[3]; float M = m;
#pragma unroll
        for (int r = 0; r < 3; ++r) { if (r < nsel) { const f32x2 v = pml[pe + r]; pm[r] = v.x; pl[r] = v.y; M = fmaxf(M, v.x); } else { pm[r] = -3.0e38f; pl[r] = 0.f; } }
        const float w4 = fast_exp2(m - M); float L = w4 * l; float wl[3];
#pragma unroll
        for (int r = 0; r < 3; ++r) { wl[r] = r < nsel ? fast_exp2(pm[r] - M) * pl[r] : 0.f; L += wl[r]; }
        const float inv = fast_rcp(L);
        bf16_t* od = qh + ((size_t)h * SEQ + t) * HD + 4 * hf;
#pragma unroll
        for (int dt = 0; dt < 2; ++dt)
#pragma unroll
            for (int gp = 0; gp < 2; ++gp) {
                float a[8];
#pragma unroll
                for (int i = 0; i < 8; ++i) a[i] = o[dt][8 * gp + i] * w4;
#pragma unroll
                for (int r = 0; r < 3; ++r) if (r < nsel) { const u32x4 v = *(const u32x4*)(po + (pe + r) * HD + 32 * hf + 16 * dt + 8 * gp);
                    a[0] += wl[r] * bf_lo(v.x); a[1] += wl[r] * bf_hi(v.x); a[2] += wl[r] * bf_lo(v.y); a[3] += wl[r] * bf_hi(v.y);
                    a[4] += wl[r] * bf_lo(v.z); a[5] += wl[r] * bf_hi(v.z); a[6] += wl[r] * bf_lo(v.w); a[7] += wl[r] * bf_hi(v.w); }
                u32x2 w0, w1; w0.x = cvt_pk_bf16(a[0] * inv, a[1] * inv); w0.y = cvt_pk_bf16(a[2] * inv, a[3] * inv); w1.x = cvt_pk_bf16(a[4] * inv, a[5] * inv); w1.y = cvt_pk_bf16(a[6] * inv, a[7] * inv);
                if (!nostore) { st8(od + 32 * dt + 16 * gp, w0); st8(od + 32 * dt + 16 * gp + 8, w1); }
            }
        asm volatile("s_waitcnt lgkmcnt(0)" ::: "memory"); __builtin_amdgcn_s_barrier(); asm volatile("" ::: "memory");
        b ^= 1;
#pragma unroll
        for (int ds = 0; ds < 4; ++ds) qf[ds] = qn[ds];
    }
}

__global__ void __launch_bounds__(NTHREADS, 2) mk_fwd(Args args) {
    extern __shared__ __attribute__((aligned(16))) unsigned char lds_raw[];
    LAS unsigned char* lds = (LAS unsigned char*)lds_raw;
    volatile LAS unsigned* misc = (volatile LAS unsigned*)(lds + RING_BYTES + 8192);
    if (!MK_MULTI) {
        if (threadIdx.x == 0) { const unsigned xcc = xb_xcc_id();
            misc[0] = xcc; misc[1] = xb_add((unsigned*)(args.ws + WS_BAR) + XB_XCNT(xcc), 1u); misc[2] = 0u; misc[3] = 0u; misc[4] = 0u; }
        __syncthreads();
    }
    for (int pp = args.ph_lo; pp < args.ph_hi; ++pp) {
        const int p = (PROBE_DUP >= 0 && pp > PROBE_DUP) ? (pp - PROBE_DUP <= PROBE_REP ? PROBE_DUP : pp - PROBE_REP) : pp; const bool isdup = PROBE_DUP >= 0 && pp > PROBE_DUP && pp - PROBE_DUP <= PROBE_REP;
        size_t wso = 0; asm volatile("" : "+s"(wso)); unsigned char* ws = args.ws + wso;
        int tid = threadIdx.x; asm volatile("" : "+v"(tid));
        int G = gridDim.x, bx = blockIdx.x; asm volatile("" : "+s"(G), "+s"(bx));
        const int lane = tid & 63, wave = __builtin_amdgcn_readfirstlane(tid >> 6);
        int cid = bx, vcu = (G % 8 == 0) ? (bx % 8) * (G / 8) + bx / 8 : bx;
        if (!MK_MULTI && pp > 0 && (G % 8) == 0) {
            if (pp == 1) {
                unsigned* xc = (unsigned*)(ws + WS_BAR); unsigned c8[8];
#pragma unroll
                for (int j = 0; j < 8; ++j) c8[j] = xb_ld(xc + XB_XCNT(j));
                bool ok = true;
#pragma unroll
                for (int j = 0; j < 8; ++j) ok = ok && ((int)c8[j] == G / 8);
                if (threadIdx.x == 0) misc[4] = ok ? 1u : 0u;
                __syncthreads();
            }
            if (misc[4]) { const int xcc = (int)misc[0], rank = (int)misc[1]; cid = rank * 8 + xcc; vcu = xcc * (G / 8) + rank; }
        }
        bx = cid;
        int kind;
        switch (p) { case 0: kind = K_PROA; break; case 1: kind = K_PROB; break; case 2: case 8: case 10: case 17: kind = K_FFNIN; break;
            case 3: case 7: case 9: case 11: case 16: case 18: kind = K_RESID; break; case 4: kind = K_GV; break; case 5: kind = K_SPATIAL; break; case 6: kind = K_GU; break;
            case 12: kind = K_QKV; break; case 13: kind = K_TOPK; break; case 14: kind = K_ATTSEL; break; case 15: kind = K_ATTOWN; break; default: kind = K_FINAL; break; }
        LAS float* rst = (LAS float*)(lds + RING_BYTES);
        float* sumsq = (float*)(ws + WS_SUMSQ); bf16_t* xb = (bf16_t*)(ws + WS_XB); bf16_t* big = (bf16_t*)(ws + WS_BIG);

        if (kind == K_PROA) {
            phase_proa(args, ws, lds, tid, lane, wave, G, bx, vcu);
        } else if (kind == K_PROB) {
            phase_prob(args, ws, lds, tid, lane, wave, G, bx, vcu);
        } else if (kind == K_FFNIN) {
            const int w = p == 2 ? 0 : (p == 8 ? 1 : (p == 10 ? 2 : 3));
            const bf16_t* Bt = (const bf16_t*)(ws + ((w >> 1) ? W1_FIN : W0_FIN) + (size_t)(w & 1) * SZ_FIN);
            pg8::Gemm g{xb, Bt, SEQ, NFF2, DM, DM, 128}; pg8::StaticOrder S; S.init(SEQ, NFF2, G, bx);
            rstd_prepass(rst, sumsq, bx & 7, tid);
            LAS float* bl = (LAS float*)(lds + RING_BYTES + 10240);
            bias_prepass(bl, (const float*)(ws + WS_BPART) + BP_F + w * 16 * NFF2, NFF2, 0, true, S, tid);
            pg8::EpiSwiGLU E{big, bl, rst};
            pg8::gemm_phase<pg8::EpiSwiGLU, true>(lds, g, S, E, tid, isdup);
            if ((p == 2 || p == 8) && !isdup) { const int nfull = S.nwg - (S.nwg / G) * G;
                if (bx >= nfull) deferred_convert(args, ws, lds, lane, wave, bx - nfull, G - nfull, p == 2 ? 0 : 1); }
        } else if (kind == K_RESID) {
            const int r = p == 3 ? 0 : (p == 7 ? 1 : (p == 9 ? 2 : (p == 11 ? 3 : (p == 16 ? 4 : 5))));
            const float* gate = isdup ? (const float*)(ws + 64 * KiB) : (const float*)(ws + WS_GATE) + r * DM;
            size_t boff = W0_FOUT; if (r == 1) boff = W0_GOUT; if (r == 2) boff = W0_FOUT + SZ_FOUT; if (r == 3) boff = W1_FOUT; if (r == 4) boff = W1_WO; if (r == 5) boff = W1_FOUT + SZ_FOUT;
            const size_t aoffb = r == 4 ? AT_Q : (r == 1 ? WS_ZV : WS_BIG);
            const int Kd = r == 1 ? GMD : (r == 4 ? DM : DFF), lda = r == 4 ? HD : Kd;
            const size_t kst = r == 4 ? (size_t)SEQ * HD * 2 : (size_t)128;
            pg8::Gemm g{(const bf16_t*)(ws + aoffb), (const bf16_t*)(ws + boff), SEQ, DM, Kd, lda, kst};
            pg8::StaticOrder S; S.init(SEQ, DM, G, bx);
            pg8::EpiResid E{xb, gate, sumsq};
            pg8::gemm_phase<pg8::EpiResid, true>(lds, g, S, E, tid, isdup);
        } else if (kind == K_GV) {
            pg8::Gemm g{xb, (const bf16_t*)(ws + W0_GIN) + (size_t)GMD * DM, SEQ, GMD, DM, DM, 128}; pg8::StaticOrder S; S.init(SEQ, GMD, G, bx);
            rstd_prepass(rst, sumsq, bx & 7, tid);
            LAS float* bl = (LAS float*)(lds + RING_BYTES + 10240);
            bias_prepass(bl, (const float*)(ws + WS_BPART) + BP_G, 6144, GMD, false, S, tid);
            pg8::EpiGeluV E{(bf16_t*)(ws + WS_ZV), bl, rst, (float*)(ws + WS_VSQ)};
            pg8::gemm_phase<pg8::EpiGeluV, true>(lds, g, S, E, tid, isdup);
        } else if (kind == K_GU) {
            pg8::Gemm g{xb, (const bf16_t*)(ws + W0_GIN), SEQ, GMD, DM, DM, 128}; pg8::StaticOrder S; S.init(SEQ, GMD, G, bx);
            rstd_prepass(rst, sumsq, bx & 7, tid);
            LAS float* bl = (LAS float*)(lds + RING_BYTES + 10240);
            bias_prepass(bl, (const float*)(ws + WS_BPART) + BP_G, 6144, 0, false, S, tid);
            pg8::EpiGeluMul E{(bf16_t*)(ws + WS_ZV), bl, rst};
            pg8::gemm_phase<pg8::EpiGeluMul, true>(lds, g, S, E, tid, isdup);
        } else if (kind == K_QKV) {
            pg8::Gemm g{xb, (const bf16_t*)(ws + W1_QKV), SEQ, 3072, DM, DM, 128}; pg8::StaticOrder S; S.init(SEQ, 3072, G, bx);
            rstd_prepass(rst, sumsq, bx & 7, tid);
            LAS float* bl = (LAS float*)(lds + RING_BYTES + 10240);
            bias_prepass(bl, (const float*)(ws + WS_BPART) + BP_Q, 3072, 0, false, S, tid);
            pg8::EpiQKV E{(bf16_t*)(ws + AT_Q), bl, rst, (float*)(ws + WS_KSUM)};
            pg8::gemm_phase<pg8::EpiQKV, true>(lds, g, S, E, tid, isdup);
        } else if (kind == K_SPATIAL) {
            phase_spatial(args, ws, lds, tid, lane, wave, G, vcu, isdup);
        } else if (kind == K_TOPK) {
            phase_topk(ws, lds, tid, lane, wave, G, vcu, isdup);
        } else if (kind == K_ATTSEL) {
            phase_attsel(ws, lds, tid, lane, wave, G, vcu, isdup);
        } else if (kind == K_ATTOWN) {
            phase_attown(ws, lds, tid, lane, wave, G, vcu, isdup);
        } else if (p >= NPHASE) {
#if PROBE_MFMA
            { f32x16 a = {}; bf16x8 x = {1, 2, 3, 4, 5, 6, 7, 8}; for (int i = 0; i < PROBE_MFMA; ++i) { a = __builtin_amdgcn_mfma_f32_32x32x16_bf16(x, x, a, 0, 0, 0); }
              if (a[0] == 1.2345f) args.out[0] = a[1]; }
#endif
        } else {
            const int gw = vcu * NWAVES + wave, NGW = G * NWAVES; const float* fn = args.in[IN_FNORM]; float* out = args.out;
            f32x4 fv[4];
#pragma unroll
            for (int j = 0; j < 4; ++j) fv[j] = *(const f32x4*)(fn + 4 * lane + 256 * j);
            const int nrow_f = (G == 256) ? 8 : (SEQ + NGW - 1 - gw) / NGW;
            for (int k0 = 0; k0 < nrow_f; k0 += 4) {
                u32x2 w[4][4]; f32x4 sq[4][4]; int mrow[4];
#pragma unroll
                for (int r = 0; r < 4; ++r) { const int k_f = k0 + r < nrow_f ? k0 + r : k0;
                    mrow[r] = (G == 256) ? (vcu >> 5) * 2048 + (vcu & 31) * 64 + wave * 8 + k_f : gw + k_f * NGW;
                    const u32x2* xr = (const u32x2*)(xb + (size_t)mrow[r] * DM) + lane; const f32x4* sp = (const f32x4*)(sumsq + (size_t)mrow[r] * 16);
#pragma unroll
                    for (int j = 0; j < 4; ++j) { w[r][j] = xr[64 * j]; sq[r][j] = sp[j]; } }
#pragma unroll
                for (int r = 0; r < 4; ++r) if (k0 + r < nrow_f) {
                    float s = 0.f;
#pragma unroll
                    for (int j = 0; j < 4; ++j) s += (sq[r][j].x + sq[r][j].y) + (sq[r][j].z + sq[r][j].w);
                    const float rs = rsqrtf(s * (1.0f / DM) + RMS_EPS); f32x4* orow = (f32x4*)(out + (size_t)mrow[r] * DM) + lane;
#pragma unroll
                    for (int j = 0; j < 4; ++j) orow[64 * j] = (f32x4){bf_lo(w[r][j].x), bf_hi(w[r][j].x), bf_lo(w[r][j].y), bf_hi(w[r][j].y)} * rs * fv[j];
                }
            }
        }
        if (pp + 1 < args.ph_hi) {
            const bool local_ok = !isdup && PROBE_DUP < 0 && misc[4] != 0u && (p == 2 || p == 3 || p == 4 || p == 6 || p == 7 || p == 8 || p == 9 || p == 10 || p == 16 || p == 17 || p == 18) && G == 256;
            if (local_ok && LOCAL_SEAMS) xcd_local_barrier((unsigned*)(args.ws + WS_BAR), misc); else xcd_barrier((unsigned*)(args.ws + WS_BAR), misc);
        }
    }
}

extern "C" void kernel_launch(void* const* d_in, const int* in_sizes, int n_in, void* d_out, int out_size, void* d_ws, size_t ws_size, hipStream_t stream) {
    static int grid = 0;
    if (grid == 0) {
        if (n_in != 16 || in_sizes[0] != SEQ * DM || out_size != SEQ * DM || ws_size < WS_END) { fprintf(stderr, "kernel_launch: unexpected shapes / workspace (%zu < %zu)\n", ws_size, (size_t)WS_END); grid = -1; return; }
        int dev = 0, cus = 0, per_cu = 0;
        hipGetDevice(&dev); hipDeviceGetAttribute(&cus, hipDeviceAttributeMultiprocessorCount, dev);
        hipFuncSetAttribute((const void*)mk_fwd, hipFuncAttributeMaxDynamicSharedMemorySize, LDS_BYTES);
        hipOccupancyMaxActiveBlocksPerMultiprocessor(&per_cu, (const void*)mk_fwd, NTHREADS, LDS_BYTES);
        if (per_cu < 1) { fprintf(stderr, "kernel_launch: occupancy query says %d blocks per CU\n", per_cu); grid = -1; return; }
        grid = cus - (cus % 8);
        (void)hipGetLastError();
    }
    if (grid < 0) return;
    hipMemsetAsync((char*)d_ws + WS_CTL, 0, CTL_BYTES, stream);
    Args a{};
    for (int i = 0; i < 16; ++i) a.in[i] = (const float*)d_in[i];
    a.out = (float*)d_out; a.ws = (unsigned char*)d_ws;
#if MK_MULTI
    for (int p = 0; p < NPHASE; ++p) { a.ph_lo = p; a.ph_hi = p + 1; hipLaunchKernelGGL(mk_fwd, dim3(grid), dim3(NTHREADS), LDS_BYTES, stream, a); }
#else
    a.ph_lo = 0; a.ph_hi = NPHASE + (PROBE_DUP >= 0 ? PROBE_REP : 0) + PROBE_NOPS;
    void* kargs[] = {&a};
    hipError_t e = hipLaunchCooperativeKernel((const void*)mk_fwd, dim3(grid), dim3(NTHREADS), kargs, LDS_BYTES, stream);
    if (e != hipSuccess) fprintf(stderr, "cooperative launch failed: %s (grid %d)\n", hipGetErrorString(e), grid);
#endif
}
```

```cpp
#include <hip/hip_runtime.h>
#include <hip/hip_cooperative_groups.h>
#include <cstdio>
#include <cstdint>
namespace cg = cooperative_groups;

#ifndef MK_MULTI
#define MK_MULTI 0
#endif

#ifndef PROBE_DUP
#define PROBE_DUP -1
#endif

#ifndef PROBE_REP
#define PROBE_REP 1
#endif
#ifndef PROBE_MFMA
#define PROBE_MFMA 0
#endif
#ifndef PROBE_ATT
#define PROBE_ATT 0
#endif
#ifndef LOCAL_SEAMS
#define LOCAL_SEAMS 1
#endif
#ifndef F8_OUT
#define F8_OUT 1
#endif
#ifndef F8_IN17
#define F8_IN17 0
#endif
#ifndef F8_IN10
#define F8_IN10 0
#endif
#ifndef I8_IN
#define I8_IN 0xF
#endif
#ifndef I8_GIN
#define I8_GIN 1
#endif
#ifndef PO8
#define PO8 1
#endif
#ifndef PROBE_NOPS
#define PROBE_NOPS 0
#endif
#ifndef PROBE_SKIPEPI
#define PROBE_SKIPEPI 0
#endif
#define LAS __attribute__((address_space(3)))
typedef unsigned short bf16_t;
typedef short bf16x8 __attribute__((ext_vector_type(8)));
typedef float f32x2 __attribute__((ext_vector_type(2)));
typedef float f32x4 __attribute__((ext_vector_type(4)));
typedef float f32x16 __attribute__((ext_vector_type(16)));
typedef unsigned u32x2 __attribute__((ext_vector_type(2)));
typedef unsigned u32x4 __attribute__((ext_vector_type(4)));

constexpr int SEQ = 16384, DM = 1024, DFF = 2816, GMD = 3072, NH = 16, HD = 64;
constexpr int NFF2 = 2 * DFF;
constexpr float RMS_EPS = 1e-6f;
constexpr float LOG2E = 1.4426950408889634f;
constexpr float QSCALE = 0.125f * LOG2E;
constexpr int NTHREADS = 512, NWAVES = 8;
constexpr float I8_XCLIP = 8.0f;
constexpr float F8_INSCALE = 32.f;
constexpr float F8_WSCALE = 64.f;

constexpr size_t KiB = 1024, MiB = 1u << 20;
constexpr size_t WS_CTL = 0, CTL_BYTES = 256 * KiB;
constexpr size_t WS_BAR = 16 * KiB;
constexpr size_t WS_MOD = 256 * KiB;
constexpr size_t WS_GAM = 328 * KiB;
constexpr size_t WS_BIASF = 352 * KiB;
constexpr size_t WS_BIASG = 440 * KiB;
constexpr size_t WS_BIASQ = 464 * KiB;
constexpr size_t WS_TAB = 476 * KiB;
constexpr size_t WS_GATE = 484 * KiB;
constexpr size_t WS_KSUM = 512 * KiB;
constexpr size_t WS_SUMSQ = 1 * MiB;
constexpr size_t WS_VSQ = 2 * MiB;
constexpr size_t WS_W1 = 5 * MiB;
constexpr size_t WS_W0 = 46 * MiB;
constexpr size_t WS_BIG = 100 * MiB;
constexpr size_t WS_ZV = 188 * MiB;
constexpr size_t WS_XB = 284 * MiB;
constexpr size_t WS_BPART = 316 * MiB;
constexpr size_t WS_CS = 318 * MiB;
constexpr size_t WS_END = 319 * MiB;
constexpr size_t WS_X8 = 148 * MiB;
constexpr int BP_F = 0, BP_G = 4 * 16 * 5632, BP_Q = BP_G + 16 * 6144;
constexpr size_t SZ_FIN = 11 * MiB, SZ_FOUT = 5767168;
constexpr size_t W1_FIN = WS_W1, W1_FOUT = WS_W1 + 22 * MiB, W1_QKV = WS_W1 + 33 * MiB, W1_WO = WS_W1 + 39 * MiB;
constexpr size_t W0_FIN = WS_W0, W0_FOUT = WS_W0 + 22 * MiB, W0_GIN = WS_W0 + 33 * MiB, W0_GOUT = WS_W0 + 45 * MiB;
constexpr size_t AT_LIST = 46 * MiB;
constexpr size_t AT_ML = 62 * MiB;
constexpr size_t AT_Q = 68 * MiB, AT_K = 100 * MiB, AT_V = 132 * MiB;
constexpr size_t AT_PO = 164 * MiB;
static_assert(AT_PO + 96 * MiB <= WS_XB, "ws map");
constexpr int LIST_PER_HEAD = 516096;

constexpr int RING_BYTES = 131072;
constexpr int LDS_BYTES = 147456 + 6144;

__device__ __forceinline__ unsigned cvt_pk_bf16(float lo, float hi) { unsigned r; asm volatile("v_cvt_pk_bf16_f32 %0, %1, %2" : "=v"(r) : "v"(lo), "v"(hi)); return r; }
__device__ __forceinline__ float bf_lo(unsigned w) { return __uint_as_float(w << 16); }
__device__ __forceinline__ float bf_hi(unsigned w) { return __uint_as_float(w & 0xffff0000u); }
__device__ __forceinline__ float bf2f(bf16_t b) { return __uint_as_float(((unsigned)b) << 16); }
__device__ __forceinline__ float fast_exp2(float x) { return __builtin_amdgcn_exp2f(x); }
__device__ __forceinline__ float fast_rcp(float x) { return __builtin_amdgcn_rcpf(x); }
__device__ __forceinline__ float silu_f(float g) { return g * fast_rcp(1.0f + fast_exp2(-g * LOG2E)); }
#ifndef WT_STORES
#define WT_STORES 0
#endif
__device__ __forceinline__ void st16(void* p, u32x4 v) {
#if WT_STORES
    asm volatile("global_store_dwordx4 %0, %1, off sc1\n\ts_nop 1" :: "v"(p), "v"(v) : "memory");
#else
    *(u32x4*)p = v;
#endif
}
__device__ __forceinline__ void st8(void* p, u32x2 v) {
#if WT_STORES
    asm volatile("global_store_dwordx2 %0, %1, off sc1\n\ts_nop 1" :: "v"(p), "v"(v) : "memory");
#else
    *(u32x2*)p = v;
#endif
}
__device__ __forceinline__ unsigned pk4_fp8(float a, float b, float c, float d) {
    a = __builtin_amdgcn_fmed3f(a, -448.f, 448.f); b = __builtin_amdgcn_fmed3f(b, -448.f, 448.f); c = __builtin_amdgcn_fmed3f(c, -448.f, 448.f); d = __builtin_amdgcn_fmed3f(d, -448.f, 448.f);
    int v = __builtin_amdgcn_cvt_pk_fp8_f32(a, b, 0, false); v = __builtin_amdgcn_cvt_pk_fp8_f32(c, d, v, true); return (unsigned)v; }
__device__ __forceinline__ unsigned pk4_i8(float a, float b, float c, float d) {
    const int ia = (int)__builtin_rintf(__builtin_amdgcn_fmed3f(a, -127.f, 127.f)), ib = (int)__builtin_rintf(__builtin_amdgcn_fmed3f(b, -127.f, 127.f));
    const int ic = (int)__builtin_rintf(__builtin_amdgcn_fmed3f(c, -127.f, 127.f)), id = (int)__builtin_rintf(__builtin_amdgcn_fmed3f(d, -127.f, 127.f));
    return (unsigned)(ia & 0xFF) | ((unsigned)(ib & 0xFF) << 8) | ((unsigned)(ic & 0xFF) << 16) | ((unsigned)id << 24); }
__device__ __forceinline__ float wave_sum(float v) {
#pragma unroll
    for (int o = 1; o < 64; o <<= 1) v += __shfl_xor(v, o);
    return v;
}
__device__ __forceinline__ float quad16_sum(float v) {
    const auto a = __builtin_amdgcn_permlane16_swap(__float_as_uint(v), __float_as_uint(v), false, false);
    v = __uint_as_float(a[0]) + __uint_as_float(a[1]);
    const auto b = __builtin_amdgcn_permlane32_swap(__float_as_uint(v), __float_as_uint(v), false, false);
    return __uint_as_float(b[0]) + __uint_as_float(b[1]);
}
__device__ __forceinline__ float row_rstd16(const float* sumsq, int row) {
    const f32x4* p = (const f32x4*)(sumsq + (size_t)row * 16);
    const f32x4 a = p[0], b = p[1], c = p[2], d = p[3];
    const float s = ((a.x + a.y) + (a.z + a.w)) + ((b.x + b.y) + (b.z + b.w)) + ((c.x + c.y) + (c.z + c.w)) + ((d.x + d.y) + (d.z + d.w));
    return rsqrtf(s * (1.0f / DM) + RMS_EPS);
}
__device__ __forceinline__ f32x2 gelu_pk(f32x2 v) {
    f32x2 t; t.x = __builtin_fminf(__builtin_fabsf(v.x), 10.f); t.y = __builtin_fminf(__builtin_fabsf(v.y), 10.f);
    f32x2 p = t * 2.992445318122927e-05f + (-0.0007398766877047824f); p = p * t + 0.007977470841739748f; p = p * t + (-0.053238198384782456f); p = p * t + (-0.45891567892813867f);
    p = p * t + (-1.1511470840561828f); p = p * t + (-1.0f);
    f32x2 r; r.x = __builtin_amdgcn_exp2f(p.x); r.y = __builtin_amdgcn_exp2f(p.y);
    f32x2 mx; mx.x = __builtin_fmaxf(v.x, 0.f); mx.y = __builtin_fmaxf(v.y, 0.f);
    return mx - t * r;
}
__device__ __forceinline__ f32x4 gelu4(f32x4 v) { const f32x2 a = gelu_pk((f32x2){v[0], v[1]}), b = gelu_pk((f32x2){v[2], v[3]}); return (f32x4){a.x, a.y, b.x, b.y}; }

namespace pg8 {
constexpr int BM = 256, BK = 64, HALF = 128, HTB = HALF * BK * 2, NXCD = 8, WGM = 8;
__host__ __device__ __forceinline__ int lds_byte(int r, int c) { const int st = (r >> 4) * 2 + (c >> 5), rr = r & 15, cc = c & 31, ob = rr * 64 + cc * 2; return st * 1024 + (ob ^ (((ob >> 9) & 1) << 5)); }
__host__ __device__ __forceinline__ void stage_rc(int b, int& R, int& C) { const int st = b / 1024, sb = b % 1024, swz = sb ^ (((sb >> 9) & 1) << 5); R = (st >> 1) * 16 + swz / 64; C = (st & 1) * 32 + (swz % 64) / 2; }
__host__ __device__ __forceinline__ int perm32(int rho) { const int n = rho >> 4, i = rho & 15; return 8 * (i >> 2) + 4 * n + (i & 3); }

typedef int i32x4 __attribute__((ext_vector_type(4)));
struct Unit { int pm, pn, idx; };
struct Gemm { const bf16_t* A; const bf16_t* Bt; int M, N, K; int lda; size_t kstepA; };

struct StaticOrder {
    int nM, nN, nwg, G, c;
    __device__ void init(int M, int N, int G_, int c_) { nM = M / BM; nN = N / BM; nwg = nM * nN; G = G_; c = c_; }
    __device__ bool next(int i, Unit& u) const {
        const long L = (long)i * G + c; if (L >= nwg) return false;
        int wgid = (int)L; { const int q = nwg / NXCD, r = nwg % NXCD, xcd = wgid % NXCD, off = wgid / NXCD; wgid = (xcd < r ? xcd * (q + 1) : r * (q + 1) + (xcd - r) * q) + off; }
        const int nig = WGM * nN, gid = wgid / nig, fm = gid * WGM, gsz = (nM - fm) < WGM ? (nM - fm) : WGM;
        u.pm = fm + ((wgid % nig) % gsz); u.pn = (wgid % nig) / gsz; u.idx = i; return true;
    }
};

template <class Epi, bool ALIGN_EPI>
__device__ __forceinline__ void gemm_phase(LAS unsigned char* lds, const Gemm g, const StaticOrder& S, const Epi& E, const int tid, const bool skip_epi = false) {
    const int wid = __builtin_amdgcn_readfirstlane(tid >> 6), lane = tid & 63, wr = wid >> 2, wc = wid & 3, fr = lane & 15, fq = lane >> 4;
    const int K = g.K, nt = K / BK;
    unsigned voffA[2], voffB[2];
#pragma unroll
    for (int i = 0; i < 2; ++i) { int R, C; stage_rc(tid * 16 + i * 8192, R, C); const int Rb = Epi::PERM ? ((R & ~31) + perm32(R & 31)) : R;
        voffA[i] = (unsigned)(R * g.lda + C) * 2u; voffB[i] = (unsigned)(Rb * K + C) * 2u; }
    const size_t kstepA = g.kstepA, kstepB = (size_t)(BK * 2);
    const size_t hstepA = (size_t)HALF * g.lda * 2, hstepB = (size_t)HALF * K * 2;
    const size_t tstepA = 2 * hstepA, tstepB = 2 * hstepB;
    const unsigned ldsw = (unsigned)wid * 1024u;
    const int aoff = lds_byte(wr * 64 + fr, fq * 8), boff = lds_byte(wc * 32 + fr, fq * 8);
#define PG8_SA(b, h) (((b) * 2 + (h)) * HTB)
#define PG8_SB(b, h) ((4 + (b) * 2 + (h)) * HTB)
#define PG8_STAGE(bufoff, gbase, voff) do { _Pragma("unroll") for (int _i = 0; _i < 2; ++_i) \
        __builtin_amdgcn_global_load_lds((const unsigned*)((const char*)(gbase) + (voff)[_i]), (LAS unsigned*)(lds + (bufoff) + ldsw + _i * 8192), 16, 0, 0); } while (0)
#define PG8_LDA(dst, b, h) do { _Pragma("unroll") for (int m = 0; m < 4; ++m) _Pragma("unroll") for (int k = 0; k < 2; ++k) dst[m][k] = *(const LAS bf16x8*)(lds + PG8_SA(b, h) + aoff + m * 2048 + k * 1024); } while (0)
#define PG8_LDB(dst, b, h) do { _Pragma("unroll") for (int n = 0; n < 2; ++n) _Pragma("unroll") for (int k = 0; k < 2; ++k) dst[n][k] = *(const LAS bf16x8*)(lds + PG8_SB(b, h) + boff + n * 2048 + k * 1024); } while (0)
#define PG8_CAT8(X) __builtin_shufflevector(__builtin_bit_cast(i32x4, (X)[0]), __builtin_bit_cast(i32x4, (X)[1]), 0, 1, 2, 3, 4, 5, 6, 7)
#define PG8_MMA(ai, bj, At, Bt) do { __builtin_amdgcn_s_setprio(1); _Pragma("unroll") for (int m = 0; m < 4; ++m) _Pragma("unroll") for (int n = 0; n < 2; ++n) { \
        if constexpr (Epi::FP8) asm volatile("v_mfma_f32_16x16x128_f8f6f4 %0, %1, %2, %0" : "+v"(acc[ai][bj][m][n]) : "v"(PG8_CAT8(Bt[n])), "v"(PG8_CAT8(At[m])));     \
        else if constexpr (Epi::I8) { _Pragma("unroll") for (int k = 0; k < 2; ++k) acc[ai][bj][m][n] = __builtin_bit_cast(f32x4, __builtin_amdgcn_mfma_i32_16x16x64_i8(__builtin_bit_cast(i32x4, Bt[n][k]), __builtin_bit_cast(i32x4, At[m][k]), __builtin_bit_cast(i32x4, acc[ai][bj][m][n]), 0, 0, 0)); } \
        else { _Pragma("unroll") for (int k = 0; k < 2; ++k) acc[ai][bj][m][n] = __builtin_amdgcn_mfma_f32_16x16x32_bf16(Bt[n][k], At[m][k], acc[ai][bj][m][n], 0, 0, 0); } } \
        __builtin_amdgcn_s_setprio(0); } while (0)
#define PG8_WAIT_V(n) asm volatile("s_waitcnt vmcnt(" #n ")" ::: "memory")
#define PG8_WAIT_L(n) asm volatile("s_waitcnt lgkmcnt(" #n ")" ::: "memory")
#define PG8_BAR __builtin_amdgcn_s_barrier()
#define PG8_SCHED __builtin_amdgcn_sched_barrier(0)
    Unit cur, nxt; int ui = 0;
    if (!S.next(0, cur)) return;
    f32x4 acc[2][2][4][2];
#pragma unroll
    for (int a = 0; a < 2; ++a)
#pragma unroll
        for (int b = 0; b < 2; ++b)
#pragma unroll
            for (int m = 0; m < 4; ++m)
#pragma unroll
                for (int n = 0; n < 2; ++n) acc[a][b][m][n] = (f32x4){0.f, 0.f, 0.f, 0.f};
    bf16x8 At[4][2], B0[2][2], B1[2][2];
    const char* cA = (const char*)g.A + (size_t)cur.pm * tstepA; const char* cB = (const char*)g.Bt + (size_t)cur.pn * tstepB;
    PG8_STAGE(PG8_SB(0, 0), cB, voffB); PG8_STAGE(PG8_SB(0, 1), cB + hstepB, voffB); PG8_STAGE(PG8_SA(0, 0), cA, voffA); PG8_STAGE(PG8_SA(0, 1), cA + hstepA, voffA);
    if (wr == 1) PG8_BAR;
    PG8_WAIT_V(2); PG8_BAR;
    PG8_STAGE(PG8_SB(1, 0), cB + kstepB, voffB); PG8_STAGE(PG8_SA(1, 0), cA + kstepA, voffA); PG8_STAGE(PG8_SB(1, 1), cB + hstepB + kstepB, voffB);
    PG8_WAIT_V(6); PG8_BAR;
    for (;;) {
        const bool has_next = S.next(ui + 1, nxt);
        const char* nA = has_next ? (const char*)g.A + (size_t)nxt.pm * tstepA : cA; const char* nB = has_next ? (const char*)g.Bt + (size_t)nxt.pn * tstepB : cB;
        for (int t = 0; t < nt; t += 2) {
            const bool last = (t == nt - 2);
            const char* a1 = cA + (size_t)(t + 1) * kstepA;
            const char* a2 = last ? nA : cA + (size_t)(t + 2) * kstepA; const char* b2 = last ? nB : cB + (size_t)(t + 2) * kstepB;
            const char* a3 = a2 + kstepA; const char* b3 = b2 + kstepB;
            PG8_LDB(B0, 0, 0); PG8_LDB(B1, 0, 1); PG8_SCHED; PG8_LDA(At, 0, 0); PG8_STAGE(PG8_SA(1, 1), a1 + hstepA, voffA);
            PG8_WAIT_V(8); PG8_WAIT_L(0); PG8_BAR; PG8_MMA(0, 0, At, B0); PG8_MMA(0, 1, At, B1); PG8_BAR; PG8_SCHED;
            PG8_LDA(At, 0, 1); PG8_STAGE(PG8_SB(0, 0), b2, voffB); PG8_STAGE(PG8_SB(0, 1), b2 + hstepB, voffB); PG8_STAGE(PG8_SA(0, 0), a2, voffA);
            PG8_WAIT_V(8); PG8_WAIT_L(0); PG8_BAR; PG8_MMA(1, 0, At, B0); PG8_MMA(1, 1, At, B1); PG8_BAR; PG8_SCHED;
            PG8_LDB(B0, 1, 0); PG8_LDB(B1, 1, 1); PG8_SCHED; PG8_LDA(At, 1, 0); PG8_STAGE(PG8_SA(0, 1), a2 + hstepA, voffA);
            PG8_WAIT_V(8); PG8_WAIT_L(0); PG8_BAR; PG8_MMA(0, 0, At, B0); PG8_MMA(0, 1, At, B1); PG8_BAR; PG8_SCHED;
            PG8_LDA(At, 1, 1); PG8_STAGE(PG8_SB(1, 0), b3, voffB); PG8_STAGE(PG8_SB(1, 1), b3 + hstepB, voffB); PG8_STAGE(PG8_SA(1, 0), a3, voffA);
            PG8_WAIT_V(8); PG8_WAIT_L(0); PG8_BAR; PG8_MMA(1, 0, At, B0); PG8_MMA(1, 1, At, B1); PG8_BAR; PG8_SCHED;
        }
        if constexpr (ALIGN_EPI) { if (wr == 0) PG8_BAR; }
        if constexpr (Epi::FP8) asm volatile("s_nop 15\n\ts_nop 15" ::: "memory");
        if (!(PROBE_SKIPEPI && skip_epi)) {
            if constexpr (Epi::FP8) { int fr2 = fr, fq2 = fq; asm volatile("" : "+v"(fr2), "+v"(fq2));
                E(acc, cur, wr, wc, fr2, fq2); }
            else E(acc, cur, wr, wc, fr, fq);
        }
        if (!has_next) break;
#pragma unroll
        for (int a = 0; a < 2; ++a)
#pragma unroll
            for (int b = 0; b < 2; ++b)
#pragma unroll
                for (int m = 0; m < 4; ++m)
#pragma unroll
                    for (int n = 0; n < 2; ++n) acc[a][b][m][n] = (f32x4){0.f, 0.f, 0.f, 0.f};
        cur = nxt; cA = nA; cB = nB; ++ui;
        if constexpr (ALIGN_EPI) { if (wr == 1) PG8_BAR; }
    }
    PG8_WAIT_V(0);
    if constexpr (!ALIGN_EPI) { if (wr == 0) PG8_BAR; }
    PG8_BAR;
#undef PG8_SA
#undef PG8_SB
#undef PG8_STAGE
#undef PG8_LDA
#undef PG8_LDB
#undef PG8_MMA
#undef PG8_CAT8
#undef PG8_WAIT_V
#undef PG8_WAIT_L
#undef PG8_BAR
#undef PG8_SCHED
}

template <int MODE_> struct EpiSwiGLUT {
    static constexpr bool PERM = true; static constexpr bool FP8 = MODE_ == 1; static constexpr bool I8 = MODE_ == 2;
    unsigned char* O; const LAS float* bias; const LAS float* rst; const LAS float* cst;
    __device__ __forceinline__ void operator()(const f32x4 (&acc)[2][2][4][2], const Unit& u, int wr, int wc, int fr, int fq) const {
        const int row0 = u.pm * BM + wr * 64 + fr, f0 = u.pn * 128 + wc * 32 + 8 * fq;
        const LAS float* bp = bias + u.idx * 256 + wc * 32 + 8 * fq;
        const f32x4 bg0 = *(const LAS f32x4*)(bp), bg1 = *(const LAS f32x4*)(bp + 4), bu0 = *(const LAS f32x4*)(bp + 128), bu1 = *(const LAS f32x4*)(bp + 132);
        f32x4 cg0, cg1, cu0, cu1;
        if constexpr (I8) { const LAS float* cp = cst + u.idx * 256 + wc * 32 + 8 * fq; cg0 = *(const LAS f32x4*)(cp); cg1 = *(const LAS f32x4*)(cp + 4); cu0 = *(const LAS f32x4*)(cp + 128); cu1 = *(const LAS f32x4*)(cp + 132); }
#pragma unroll
        for (int ai = 0; ai < 2; ++ai)
#pragma unroll
            for (int m = 0; m < 4; ++m) {
                const int row = row0 + ai * HALF + m * 16; const float rs = rst[(u.pm & 7) * 256 + ai * HALF + wr * 64 + m * 16 + fr];
                const f32x2 rs2 = (f32x2){rs, rs};
                u32x4 w; u32x2 w8;
#pragma unroll
                for (int n = 0; n < 2; ++n) {
                    f32x4 ag = acc[ai][0][m][n], au = acc[ai][1][m][n]; const f32x4 bgv = n ? bg1 : bg0, buv = n ? bu1 : bu0;
                    if constexpr (I8) { const i32x4 ig = __builtin_bit_cast(i32x4, ag), iu = __builtin_bit_cast(i32x4, au); const f32x4 cgv = n ? cg1 : cg0, cuv = n ? cu1 : cu0;
                        ag = (f32x4){(float)ig[0], (float)ig[1], (float)ig[2], (float)ig[3]} * cgv; au = (f32x4){(float)iu[0], (float)iu[1], (float)iu[2], (float)iu[3]} * cuv; }
                    unsigned pk[2]; f32x2 hq[2];
#pragma unroll
                    for (int hh = 0; hh < 2; ++hh) {
                        const f32x2 g = (f32x2){ag[2 * hh], ag[2 * hh + 1]} * rs2 + (f32x2){bgv[2 * hh], bgv[2 * hh + 1]};
                        const f32x2 uu = (f32x2){au[2 * hh], au[2 * hh + 1]} * rs2 + (f32x2){buv[2 * hh], buv[2 * hh + 1]};
                        const f32x2 t = g * (-LOG2E);
                        f32x2 e; e.x = fast_exp2(t.x); e.y = fast_exp2(t.y);
                        const f32x2 d = e + 1.0f;
                        f32x2 r; r.x = fast_rcp(d.x); r.y = fast_rcp(d.y);
                        const f32x2 hv = (g * uu) * r;
                        if (F8_OUT) hq[hh] = hv; else pk[hh] = cvt_pk_bf16(hv.x, hv.y);
                    }
                    if (F8_OUT) { const unsigned q = pk4_fp8(hq[0].x, hq[0].y, hq[1].x, hq[1].y); if (n == 0) w8.x = q; else w8.y = q; }
                    else if (n == 0) { w.x = pk[0]; w.y = pk[1]; } else { w.z = pk[0]; w.w = pk[1]; }
                }
                if (F8_OUT) st8(O + (size_t)row * DFF + f0, w8); else st16(O + ((size_t)row * DFF + f0) * 2, w);
                asm volatile("" ::: "memory");
            }
    }
};
using EpiSwiGLU = EpiSwiGLUT<0>; using EpiSwiGLUF8 = EpiSwiGLUT<1>; using EpiSwiGLUI8 = EpiSwiGLUT<2>;
template <bool F8_> struct EpiResidT {
    static constexpr bool PERM = true; static constexpr bool FP8 = F8_; static constexpr bool I8 = false;
    bf16_t* xb; const float* gate; float* sumsq; unsigned char* x8; bool xi8;
    __device__ __forceinline__ void operator()(const f32x4 (&acc)[2][2][4][2], const Unit& u, int wr, int wc, int fr, int fq) const {
        const int row0 = u.pm * BM + wr * 64 + fr, c0 = u.pn * BM + wc * 32 + 8 * fq;
        f32x4 gv[2][2];
#pragma unroll
        for (int bj = 0; bj < 2; ++bj)
#pragma unroll
            for (int n = 0; n < 2; ++n) gv[bj][n] = *(const f32x4*)(gate + c0 + bj * HALF + 4 * n);
#pragma unroll
        for (int ai = 0; ai < 2; ++ai) {
            u32x4 xs[4][2];
#pragma unroll
            for (int m = 0; m < 4; ++m)
#pragma unroll
                for (int bj = 0; bj < 2; ++bj) xs[m][bj] = *(const u32x4*)(xb + (size_t)(row0 + ai * HALF + m * 16) * DM + c0 + bj * HALF);
#pragma unroll
            for (int m = 0; m < 4; ++m) {
                const int row = row0 + ai * HALF + m * 16; float ss = 0.f;
#pragma unroll
                for (int bj = 0; bj < 2; ++bj) {
                    u32x4* p = (u32x4*)(xb + (size_t)row * DM + c0 + bj * HALF); const u32x4 s = xs[m][bj];
                    const f32x4 v0 = (f32x4){bf_lo(s.x), bf_hi(s.x), bf_lo(s.y), bf_hi(s.y)} + gv[bj][0] * acc[ai][bj][m][0];
                    const f32x4 v1 = (f32x4){bf_lo(s.z), bf_hi(s.z), bf_lo(s.w), bf_hi(s.w)} + gv[bj][1] * acc[ai][bj][m][1];
                    ss += ((v0[0] * v0[0] + v0[1] * v0[1]) + (v0[2] * v0[2] + v0[3] * v0[3])) + ((v1[0] * v1[0] + v1[1] * v1[1]) + (v1[2] * v1[2] + v1[3] * v1[3]));
                    u32x4 w; w.x = cvt_pk_bf16(v0[0], v0[1]); w.y = cvt_pk_bf16(v0[2], v0[3]); w.z = cvt_pk_bf16(v1[0], v1[1]); w.w = cvt_pk_bf16(v1[2], v1[3]);
                    st16(p, w);
                    if (x8) { constexpr float QX = 127.0f / I8_XCLIP;
                        if (xi8) st8(x8 + (size_t)row * DM + c0 + bj * HALF, (u32x2){pk4_i8(v0[0] * QX, v0[1] * QX, v0[2] * QX, v0[3] * QX), pk4_i8(v1[0] * QX, v1[1] * QX, v1[2] * QX, v1[3] * QX)});
                        else st8(x8 + (size_t)row * DM + c0 + bj * HALF, (u32x2){pk4_fp8(v0[0], v0[1], v0[2], v0[3]), pk4_fp8(v1[0], v1[1], v1[2], v1[3])}); }
                }
                ss = quad16_sum(ss);
                if (fq == 0) sumsq[(size_t)row * 16 + u.pn * 4 + wc] = ss;
            }
            asm volatile("" ::: "memory");
        }
    }
};
using EpiResid = EpiResidT<false>; using EpiResidF8 = EpiResidT<true>;
template <bool I8_> struct EpiGeluVT {
    static constexpr bool PERM = true; static constexpr bool FP8 = false; static constexpr bool I8 = I8_;
    const LAS float* cst;
    bf16_t* O; const LAS float* bias; const LAS float* rst; float* vsq;
    __device__ __forceinline__ void operator()(const f32x4 (&acc)[2][2][4][2], const Unit& u, int wr, int wc, int fr, int fq) const {
        const int row0 = u.pm * BM + wr * 64 + fr, c0 = u.pn * BM + wc * 32 + 8 * fq;
        f32x4 bv[2][2], cv[2][2];
#define EPI_DQ(A, C) (I8 ? (f32x4){(float)__builtin_bit_cast(i32x4, (A))[0], (float)__builtin_bit_cast(i32x4, (A))[1], (float)__builtin_bit_cast(i32x4, (A))[2], (float)__builtin_bit_cast(i32x4, (A))[3]} * (C) : (A))
#pragma unroll
        for (int bj = 0; bj < 2; ++bj)
#pragma unroll
            for (int n = 0; n < 2; ++n) { bv[bj][n] = *(const LAS f32x4*)(bias + u.idx * 256 + wc * 32 + 8 * fq + bj * HALF + 4 * n); if constexpr (I8) cv[bj][n] = *(const LAS f32x4*)(cst + u.idx * 256 + wc * 32 + 8 * fq + bj * HALF + 4 * n); }
#pragma unroll
        for (int ai = 0; ai < 2; ++ai)
#pragma unroll
            for (int m = 0; m < 4; ++m) {
                const int row = row0 + ai * HALF + m * 16; const float rs = rst[(u.pm & 7) * 256 + ai * HALF + wr * 64 + m * 16 + fr]; float ss = 0.f;
#pragma unroll
                for (int bj = 0; bj < 2; ++bj) {
                    const f32x4 v0 = gelu4(EPI_DQ(acc[ai][bj][m][0], cv[bj][0]) * rs + bv[bj][0]), v1 = gelu4(EPI_DQ(acc[ai][bj][m][1], cv[bj][1]) * rs + bv[bj][1]);
                    ss += ((v0[0] * v0[0] + v0[1] * v0[1]) + (v0[2] * v0[2] + v0[3] * v0[3])) + ((v1[0] * v1[0] + v1[1] * v1[1]) + (v1[2] * v1[2] + v1[3] * v1[3]));
                    u32x4 w; w.x = cvt_pk_bf16(v0[0], v0[1]); w.y = cvt_pk_bf16(v0[2], v0[3]); w.z = cvt_pk_bf16(v1[0], v1[1]); w.w = cvt_pk_bf16(v1[2], v1[3]);
                    st16(O + (size_t)row * GMD + c0 + bj * HALF, w);
                }
                ss = quad16_sum(ss);
                if (fq == 0) vsq[(size_t)row * 48 + u.pn * 4 + wc] = ss;
                asm volatile("" ::: "memory");
            }
    }
};
#undef EPI_DQ
using EpiGeluV = EpiGeluVT<false>; using EpiGeluVI8 = EpiGeluVT<true>;
template <bool I8_> struct EpiGeluMulT {
    static constexpr bool PERM = true; static constexpr bool FP8 = false; static constexpr bool I8 = I8_;
    const LAS float* cst;
    bf16_t* SV; const LAS float* bias; const LAS float* rst; bool ns;
    __device__ __forceinline__ void operator()(const f32x4 (&acc)[2][2][4][2], const Unit& u, int wr, int wc, int fr, int fq) const {
        const int row0 = u.pm * BM + wr * 64 + fr, c0 = u.pn * BM + wc * 32 + 8 * fq;
        f32x4 bv[2][2], cv[2][2];
#define EPI_DQ(A, C) (I8 ? (f32x4){(float)__builtin_bit_cast(i32x4, (A))[0], (float)__builtin_bit_cast(i32x4, (A))[1], (float)__builtin_bit_cast(i32x4, (A))[2], (float)__builtin_bit_cast(i32x4, (A))[3]} * (C) : (A))
#pragma unroll
        for (int bj = 0; bj < 2; ++bj)
#pragma unroll
            for (int n = 0; n < 2; ++n) { bv[bj][n] = *(const LAS f32x4*)(bias + u.idx * 256 + wc * 32 + 8 * fq + bj * HALF + 4 * n); if constexpr (I8) cv[bj][n] = *(const LAS f32x4*)(cst + u.idx * 256 + wc * 32 + 8 * fq + bj * HALF + 4 * n); }
#pragma unroll
        for (int ai = 0; ai < 2; ++ai) {
            u32x4 xs[4][2];
#pragma unroll
            for (int m = 0; m < 4; ++m)
#pragma unroll
                for (int bj = 0; bj < 2; ++bj) xs[m][bj] = *(const u32x4*)(SV + (size_t)(row0 + ai * HALF + m * 16) * GMD + c0 + bj * HALF);
#pragma unroll
            for (int m = 0; m < 4; ++m) {
                const int row = row0 + ai * HALF + m * 16; const float rs = rst[(u.pm & 7) * 256 + ai * HALF + wr * 64 + m * 16 + fr];
#pragma unroll
                for (int bj = 0; bj < 2; ++bj) {
                    u32x4* p = (u32x4*)(SV + (size_t)row * GMD + c0 + bj * HALF); const u32x4 s = xs[m][bj];
                    const f32x4 v0 = gelu4(EPI_DQ(acc[ai][bj][m][0], cv[bj][0]) * rs + bv[bj][0]), v1 = gelu4(EPI_DQ(acc[ai][bj][m][1], cv[bj][1]) * rs + bv[bj][1]);
                    u32x4 w; w.x = cvt_pk_bf16(v0[0] * bf_lo(s.x), v0[1] * bf_hi(s.x)); w.y = cvt_pk_bf16(v0[2] * bf_lo(s.y), v0[3] * bf_hi(s.y));
                    w.z = cvt_pk_bf16(v1[0] * bf_lo(s.z), v1[1] * bf_hi(s.z)); w.w = cvt_pk_bf16(v1[2] * bf_lo(s.w), v1[3] * bf_hi(s.w));
                    if (!(PROBE_DUP >= 0 && ns)) st16(p, w);
                }
                asm volatile("" ::: "memory");
            }
        }
    }
};
#undef EPI_DQ
using EpiGeluMul = EpiGeluMulT<false>; using EpiGeluMulI8 = EpiGeluMulT<true>;
struct EpiQKV {
    static constexpr bool PERM = true; static constexpr bool FP8 = false; static constexpr bool I8 = false;
    bf16_t* QKV; const LAS float* bias; const LAS float* rst; float* ksum;
    __device__ __forceinline__ void operator()(const f32x4 (&acc)[2][2][4][2], const Unit& u, int wr, int wc, int fr, int fq) const {
        const int which = u.pn >> 2;
        const int row0 = u.pm * BM + wr * 64 + fr, cb = (u.pn & 3) * BM + wc * 32 + 8 * fq;
        bf16_t* base = QKV + (size_t)which * ((size_t)SEQ * DM);
        const float sc = which == 0 ? QSCALE : 1.0f;
        f32x4 bv[2][2], cs[2][2];
#pragma unroll
        for (int bj = 0; bj < 2; ++bj)
#pragma unroll
            for (int n = 0; n < 2; ++n) { bv[bj][n] = *(const LAS f32x4*)(bias + u.idx * 256 + wc * 32 + 8 * fq + bj * HALF + 4 * n); cs[bj][n] = (f32x4){0.f, 0.f, 0.f, 0.f}; }
#pragma unroll
        for (int ai = 0; ai < 2; ++ai)
#pragma unroll
            for (int m = 0; m < 4; ++m) {
                const int row = row0 + ai * HALF + m * 16; const float rs = rst[(u.pm & 7) * 256 + ai * HALF + wr * 64 + m * 16 + fr];
#pragma unroll
                for (int bj = 0; bj < 2; ++bj) {
                    const int c = cb + bj * HALF; const int head = c >> 6, d = c & 63;
                    f32x4 v0 = acc[ai][bj][m][0] * rs + bv[bj][0], v1 = acc[ai][bj][m][1] * rs + bv[bj][1];
                    cs[bj][0] += v0; cs[bj][1] += v1;
                    v0 = v0 * sc; v1 = v1 * sc;
                    u32x4 w; w.x = cvt_pk_bf16(v0[0], v0[1]); w.y = cvt_pk_bf16(v0[2], v0[3]); w.z = cvt_pk_bf16(v1[0], v1[1]); w.w = cvt_pk_bf16(v1[2], v1[3]);
                    st16(base + ((size_t)head * SEQ + row) * HD + d, w);
                }
                asm volatile("" ::: "memory");
            }
        if (which == 1) {
#pragma unroll
            for (int bj = 0; bj < 2; ++bj)
#pragma unroll
                for (int n = 0; n < 2; ++n) {
                    f32x4 s = cs[bj][n];
#pragma unroll
                    for (int o = 1; o < 16; o <<= 1) { s[0] += __shfl_xor(s[0], o); s[1] += __shfl_xor(s[1], o); s[2] += __shfl_xor(s[2], o); s[3] += __shfl_xor(s[3], o); }
                    if (fr == 0) *(f32x4*)(ksum + ((size_t)u.pm * 2 + wr) * DM + cb + bj * HALF + 4 * n) = s;
                }
        }
    }
};
}

struct Args { const float* in[16]; float* out; unsigned char* ws; int ph_lo, ph_hi; };
enum { IN_X = 0, IN_C, IN_RELB, IN_MODW, IN_MODB, IN_NORMG, IN_FWIN, IN_FWOUT, IN_GWIN, IN_GVN, IN_GWS, IN_GBS, IN_GWOUT, IN_WQKV, IN_WO, IN_FNORM };

__device__ __forceinline__ unsigned f2bf(float f) { unsigned u = __builtin_bit_cast(unsigned, f); return (u + 0x7fffu + ((u >> 16) & 1u)) >> 16; }
__device__ __forceinline__ unsigned pk2(float lo, float hi) { return f2bf(lo) | (f2bf(hi) << 16); }
__device__ __forceinline__ void transpose_item(const float* W, int K, int N, bf16_t* WT, int mode, LAS float* scr, int item, int lane, const float* ng = nullptr, const float* sc = nullptr, const float* shift = nullptr, float* bpart = nullptr, float f8s = 0.f) {
    const int nblk = N / 32, kb = item / nblk, nb = item % nblk, k0 = 64 * kb, n0 = 32 * nb;
    int r0 = n0;
    if (mode == 1) { const int up = n0 >= DFF ? 1 : 0, f0 = n0 - up * DFF; r0 = (f0 >> 7) * 256 + up * 128 + (f0 & 127); }
    { f32x4 v[8]; const float* wp = W + (size_t)(k0 + (lane >> 3)) * N + n0 + 4 * (lane & 7);
#pragma unroll
      for (int i = 0; i < 8; ++i) v[i] = *(const f32x4*)(wp + (size_t)(8 * i) * N);
      if (bpart) {
          f32x4 ps = (f32x4){0.f, 0.f, 0.f, 0.f};
#pragma unroll
          for (int i = 0; i < 8; ++i) ps += v[i] * shift[k0 + (lane >> 3) + 8 * i];
#pragma unroll
          for (int o = 8; o < 64; o <<= 1) { ps[0] += __shfl_xor(ps[0], o); ps[1] += __shfl_xor(ps[1], o); ps[2] += __shfl_xor(ps[2], o); ps[3] += __shfl_xor(ps[3], o); }
          if (lane < 8) *(f32x4*)(bpart + (size_t)kb * N + n0 + 4 * lane) = ps;
      }
#pragma unroll
      for (int i = 0; i < 8; ++i) { LAS float* d = scr + ((lane >> 3) + 8 * i) * 33 + 4 * (lane & 7); d[0] = v[i][0]; d[1] = v[i][1]; d[2] = v[i][2]; d[3] = v[i][3]; } }
    asm volatile("s_waitcnt lgkmcnt(0)" ::: "memory");
    const int c = lane & 7;
    f32x4 g0 = (f32x4){1.f, 1.f, 1.f, 1.f}, g1 = g0;
    if (ng) { g0 = *(const f32x4*)(ng + k0 + 8 * c) * (*(const f32x4*)(sc + k0 + 8 * c) + 1.0f); g1 = *(const f32x4*)(ng + k0 + 8 * c + 4) * (*(const f32x4*)(sc + k0 + 8 * c + 4) + 1.0f); }
#pragma unroll
    for (int j = 0; j < 4; ++j) { const int n = (lane >> 3) + 8 * j; const LAS float* s = scr + (8 * c) * 33 + n;
        if (f8s != 0.f) { u32x2 o8; const f32x4 h0 = g0 * f8s, h1 = g1 * f8s; o8.x = pk4_fp8(s[0 * 33] * h0[0], s[1 * 33] * h0[1], s[2 * 33] * h0[2], s[3 * 33] * h0[3]); o8.y = pk4_fp8(s[4 * 33] * h1[0], s[5 * 33] * h1[1], s[6 * 33] * h1[2], s[7 * 33] * h1[3]);
            *(u32x2*)((unsigned char*)WT + (size_t)(r0 + n) * K + k0 + 8 * c) = o8; continue; }
        u32x4 o; o.x = pk2(s[0 * 33] * g0[0], s[1 * 33] * g0[1]); o.y = pk2(s[2 * 33] * g0[2], s[3 * 33] * g0[3]); o.z = pk2(s[4 * 33] * g1[0], s[5 * 33] * g1[1]); o.w = pk2(s[6 * 33] * g1[2], s[7 * 33] * g1[3]);
        *(u32x4*)(WT + (size_t)(r0 + n) * K + k0 + 8 * c) = o; }
    asm volatile("s_waitcnt lgkmcnt(0)" ::: "memory");
}
__device__ __forceinline__ void convert_i8_item(const float* W, int N, unsigned char* WT, LAS float* scr, LAS float* cm, int nb, int lane, int wave,
                                                const float* ng, const float* sc, const float* shift, float* bpart, float* cs, int mode = 1) {
    const int n0 = 32 * nb, up = n0 >= DFF ? 1 : 0, f0 = n0 - up * DFF, r0 = mode ? (f0 >> 7) * 256 + up * 128 + (f0 & 127) : n0;
    f32x4 u[2][8]; f32x4 mx = (f32x4){0.f, 0.f, 0.f, 0.f};
#pragma unroll
    for (int b = 0; b < 2; ++b) { const int kb = 2 * wave + b, k0 = 64 * kb;
        const float* wp = W + (size_t)(k0 + (lane >> 3)) * N + n0 + 4 * (lane & 7);
#pragma unroll
        for (int i = 0; i < 8; ++i) u[b][i] = *(const f32x4*)(wp + (size_t)(8 * i) * N);
        f32x4 ps = (f32x4){0.f, 0.f, 0.f, 0.f};
#pragma unroll
        for (int i = 0; i < 8; ++i) { const int k = k0 + (lane >> 3) + 8 * i; ps += u[b][i] * shift[k]; u[b][i] = u[b][i] * (ng[k] * (sc[k] + 1.0f));
            mx[0] = fmaxf(mx[0], fabsf(u[b][i][0])); mx[1] = fmaxf(mx[1], fabsf(u[b][i][1])); mx[2] = fmaxf(mx[2], fabsf(u[b][i][2])); mx[3] = fmaxf(mx[3], fabsf(u[b][i][3])); }
#pragma unroll
        for (int o = 8; o < 64; o <<= 1) { ps[0] += __shfl_xor(ps[0], o); ps[1] += __shfl_xor(ps[1], o); ps[2] += __shfl_xor(ps[2], o); ps[3] += __shfl_xor(ps[3], o); }
        if (lane < 8) *(f32x4*)(bpart + (size_t)kb * N + n0 + 4 * lane) = ps;
    }
#pragma unroll
    for (int o = 8; o < 64; o <<= 1) { mx[0] = fmaxf(mx[0], __shfl_xor(mx[0], o)); mx[1] = fmaxf(mx[1], __shfl_xor(mx[1], o)); mx[2] = fmaxf(mx[2], __shfl_xor(mx[2], o)); mx[3] = fmaxf(mx[3], __shfl_xor(mx[3], o)); }
    __syncthreads();
    if (lane < 8) *(LAS f32x4*)(cm + wave * 32 + 4 * lane) = mx;
    __syncthreads();
    f32x4 cmx = *(const LAS f32x4*)(cm + 4 * (lane & 7));
#pragma unroll
    for (int w2 = 1; w2 < 8; ++w2) { const f32x4 t = *(const LAS f32x4*)(cm + w2 * 32 + 4 * (lane & 7)); cmx[0] = fmaxf(cmx[0], t[0]); cmx[1] = fmaxf(cmx[1], t[1]); cmx[2] = fmaxf(cmx[2], t[2]); cmx[3] = fmaxf(cmx[3], t[3]); }
    cmx[0] = fmaxf(cmx[0], 1e-30f); cmx[1] = fmaxf(cmx[1], 1e-30f); cmx[2] = fmaxf(cmx[2], 1e-30f); cmx[3] = fmaxf(cmx[3], 1e-30f);
    if (wave == 0 && lane < 8) *(f32x4*)(cs + n0 + 4 * lane) = cmx * (1.0f / 127.0f);
    const f32x4 q = (f32x4){127.0f / cmx[0], 127.0f / cmx[1], 127.0f / cmx[2], 127.0f / cmx[3]};
#pragma unroll
    for (int b = 0; b < 2; ++b) { const int k0 = 64 * (2 * wave + b);
#pragma unroll
        for (int i = 0; i < 8; ++i) { LAS float* d = scr + ((lane >> 3) + 8 * i) * 33 + 4 * (lane & 7); const f32x4 t = u[b][i] * q; d[0] = t[0]; d[1] = t[1]; d[2] = t[2]; d[3] = t[3]; }
        asm volatile("s_waitcnt lgkmcnt(0)" ::: "memory");
        const int c = lane & 7;
#pragma unroll
        for (int j = 0; j < 4; ++j) { const int n = (lane >> 3) + 8 * j; const LAS float* s = scr + (8 * c) * 33 + n;
            u32x2 o8; o8.x = pk4_i8(s[0 * 33], s[1 * 33], s[2 * 33], s[3 * 33]); o8.y = pk4_i8(s[4 * 33], s[5 * 33], s[6 * 33], s[7 * 33]);
            *(u32x2*)(WT + (size_t)(r0 + n) * DM + k0 + 8 * c) = o8; }
        asm volatile("s_waitcnt lgkmcnt(0)" ::: "memory");
    }
}
template <bool SILU>
__device__ __forceinline__ void colsum_item(const float* W, int ldw, int n0, const float* svec, const float* addb, float* out, LAS f32x4* red, int tid) {
    const int cgp = tid & 31, ks = tid >> 5;
    f32x4 acc = (f32x4){0.f, 0.f, 0.f, 0.f};
    const float* wp = W + (size_t)(ks * 64) * ldw + n0 + 4 * cgp;
#pragma unroll 16
    for (int kk = 0; kk < 64; ++kk) { float s = svec[ks * 64 + kk]; if (SILU) s = s / (1.0f + __expf(-s)); acc += *(const f32x4*)(wp + (size_t)kk * ldw) * s; }
    red[ks * 32 + cgp] = acc;
    __syncthreads();
    if (tid < 32) { f32x4 s = red[tid];
#pragma unroll
        for (int j = 1; j < 16; ++j) s += red[j * 32 + tid];
        if (addb) s += *(const f32x4*)(addb + n0 + 4 * tid);
        *(f32x4*)(out + n0 + 4 * tid) = s; }
    __syncthreads();
}

typedef short v4i16_t __attribute__((ext_vector_type(4)));
__device__ __forceinline__ int swap23(int i) { return (i & 0x13) | ((i & 4) << 1) | ((i & 8) >> 1); }
__device__ __forceinline__ void dma_kv(LAS unsigned char* buf, const bf16_t* kblk, const bf16_t* vblk, int tid, int wave) {
#pragma unroll
    for (int i = 0; i < 4; ++i) { const int p = i * 512 + tid, row = p >> 3, c = (p & 7) ^ ((row >> 1) & 7);
        __builtin_amdgcn_global_load_lds((const unsigned*)((const char*)kblk + row * 128 + c * 16), (LAS unsigned*)(buf + i * 8192 + wave * 1024), 16, 0, 0); }
#pragma unroll
    for (int i = 0; i < 4; ++i) { const int p = i * 512 + tid, row = p >> 3, c = (p & 7) ^ (((row >> 1) & 1) << 2);
        __builtin_amdgcn_global_load_lds((const unsigned*)((const char*)vblk + row * 128 + c * 16), (LAS unsigned*)(buf + 32768 + i * 8192 + wave * 1024), 16, 0, 0); }
}
__device__ __forceinline__ float halfmax(float m) {
    const auto rr = __builtin_amdgcn_permlane32_swap(__float_as_uint(m), __float_as_uint(m), false, false);
    return fmaxf(__uint_as_float(rr[0]), __uint_as_float(rr[1]));
}
__device__ __forceinline__ float halfsum(float m) {
    const auto rr = __builtin_amdgcn_permlane32_swap(__float_as_uint(m), __float_as_uint(m), false, false);
    return __uint_as_float(rr[0]) + __uint_as_float(rr[1]);
}
#define MX3(a, b, c) __builtin_fmaxf(__builtin_fmaxf((a), (b)), (c))
template <int MODE>
__device__ __forceinline__ void attn_tile(const bf16x8 (&qf)[4], const LAS unsigned char* kbuf, const LAS unsigned char* vbuf, const LAS float* tabd, int kpos0, int nkt, int tq, int lane,
                                          float& m_out, float& l_out, f32x16 (&o)[2]) {
    const int r32 = lane & 31, hf = lane >> 5;
    const int krow = swap23(r32), kkey = (krow >> 1) & 7;
    const LAS unsigned char* kp = kbuf + krow * 128;
    const int g16 = lane >> 4, q4 = (lane & 15) >> 2, p4 = lane & 3, vkey = ((q4 >> 1) & 1) << 2;
    const LAS unsigned char* vb0 = vbuf + (8 * hf + q4) * 128 + (p4 & 1) * 8;
    const int vc0 = ((2 * (g16 & 1) + (p4 >> 1)) ^ vkey) << 4, vc1 = ((4 + 2 * (g16 & 1) + (p4 >> 1)) ^ vkey) << 4;
    const float b31 = tabd[128];
    float mref = 0.f, l = 0.f;
    f32x16 negc;
#pragma unroll
    for (int r = 0; r < 16; ++r) negc[r] = b31;
    o[0] = (f32x16){}; o[1] = (f32x16){};
#define AT_KS(S, KT) do { bf16x8 kf_[4]; _Pragma("unroll") for (int ds = 0; ds < 4; ++ds) kf_[ds] = *(const LAS bf16x8*)(kp + (KT) * 4096 + (((2 * ds + hf) ^ kkey) << 4)); \
        S = __builtin_amdgcn_mfma_f32_32x32x16_bf16(kf_[0], qf[0], negc, 0, 0, 0); _Pragma("unroll") for (int ds = 1; ds < 4; ++ds) S = __builtin_amdgcn_mfma_f32_32x32x16_bf16(kf_[ds], qf[ds], S, 0, 0, 0); } while (0)
#define AT_FIX(S, KT) do { const int dbase_ = tq - (kpos0 + 32 * (KT) + 8 * hf); if (__any(dbase_ - 23 < 113)) { _Pragma("unroll") for (int r = 0; r < 16; ++r) { const int dist = dbase_ - 16 * (r >> 3) - (r & 7); \
        float v = S[r] + tabd[dist < 0 ? 0 : (dist > 127 ? 127 : dist)]; if (MODE == 1 && dist < 0) v = -1.0e30f; S[r] = v; } } } while (0)
#define AT_PV(S, KT) do { _Pragma("unroll") for (int sx = 0; sx < 2; ++sx) { \
        u32x4 pw; pw.x = cvt_pk_bf16(S[8 * sx + 0], S[8 * sx + 1]); pw.y = cvt_pk_bf16(S[8 * sx + 2], S[8 * sx + 3]); pw.z = cvt_pk_bf16(S[8 * sx + 4], S[8 * sx + 5]); pw.w = cvt_pk_bf16(S[8 * sx + 6], S[8 * sx + 7]); \
        const bf16x8 pb = __builtin_bit_cast(bf16x8, pw); const LAS unsigned char* vr = vb0 + (32 * (KT) + 16 * sx) * 128; \
        const v4i16_t a0 = __builtin_amdgcn_ds_read_tr16_b64_v4i16((LAS v4i16_t*)(vr + vc0)), a1 = __builtin_amdgcn_ds_read_tr16_b64_v4i16((LAS v4i16_t*)(vr + 512 + vc0)); \
        const v4i16_t b0 = __builtin_amdgcn_ds_read_tr16_b64_v4i16((LAS v4i16_t*)(vr + vc1)), b1 = __builtin_amdgcn_ds_read_tr16_b64_v4i16((LAS v4i16_t*)(vr + 512 + vc1)); \
        o[0] = __builtin_amdgcn_mfma_f32_32x32x16_bf16((bf16x8){a0[0], a0[1], a0[2], a0[3], a1[0], a1[1], a1[2], a1[3]}, pb, o[0], 0, 0, 0); \
        o[1] = __builtin_amdgcn_mfma_f32_32x32x16_bf16((bf16x8){b0[0], b0[1], b0[2], b0[3], b1[0], b1[1], b1[2], b1[3]}, pb, o[1], 0, 0, 0); } } while (0)
    for (int kt = 0; kt < nkt; kt += 2) {
        const bool two = kt + 1 < nkt;
        f32x16 s0, s1;
        AT_KS(s0, kt);
        if (two) AT_KS(s1, kt + 1); else {
#pragma unroll
            for (int r = 0; r < 16; ++r) s1[r] = -1.0e30f; }
        AT_FIX(s0, kt);
        if (two) AT_FIX(s1, kt + 1);
        float ma = MX3(s0[0], s0[1], s1[0]), mb = MX3(s0[2], s0[3], s1[1]); ma = MX3(ma, s1[2], s1[3]);
#pragma unroll
        for (int r = 4; r < 16; r += 4) { ma = MX3(ma, s0[r], s0[r + 1]); mb = MX3(mb, s0[r + 2], s0[r + 3]); ma = MX3(ma, s1[r], s1[r + 1]); mb = MX3(mb, s1[r + 2], s1[r + 3]); }
        const float mx = halfmax(fmaxf(ma, mb));
        if (kt == 0 || __any(mx > 8.0f)) {
            const float dl = kt == 0 ? mx : fmaxf(mx, 0.f); mref += dl;
#pragma unroll
            for (int r = 0; r < 16; ++r) { s0[r] -= dl; s1[r] -= dl; negc[r] -= dl; }
            if (kt != 0) { const float f = fast_exp2(-dl); l *= f; o[0] = o[0] * f; o[1] = o[1] * f; }
        }
#pragma unroll
        for (int r = 0; r < 16; ++r) s0[r] = fast_exp2(s0[r]);
        float la = (s0[0] + s0[1]) + (s0[2] + s0[3]);
#pragma unroll
        for (int r = 4; r < 16; r += 4) la += (s0[r] + s0[r + 1]) + (s0[r + 2] + s0[r + 3]);
        AT_PV(s0, kt);
#pragma unroll
        for (int r = 0; r < 16; ++r) s1[r] = fast_exp2(s1[r]);
        float lb = (s1[0] + s1[1]) + (s1[2] + s1[3]);
#pragma unroll
        for (int r = 4; r < 16; r += 4) lb += (s1[r] + s1[r + 1]) + (s1[r + 2] + s1[r + 3]);
#pragma unroll
        for (int i_ = 0; i_ < 4; ++i_) { __builtin_amdgcn_sched_group_barrier(0x8, 1, 0); __builtin_amdgcn_sched_group_barrier(0x2, 6, 0); }
        l += la + lb;
        if (two) AT_PV(s1, kt + 1);
    }
#undef AT_KS
#undef AT_FIX
#undef AT_PV
    l = halfsum(l);
    m_out = mref; l_out = l;
}
__device__ __forceinline__ int list_base(int h, int n) { return h * LIST_PER_HEAD + 256 * (63 * n - (n * (n - 1)) / 2); }

#define XB_TMO      128
#define XB_XCNT(j)  (256  + 64 * (j))
#define XB_XSUB(j)  (1280 + 64 * (j))
#define XB_XGEN(j)  (2304 + 64 * (j))
#define XB_TOP      3328
#define XB_TOPGEN   3392
#define XCD_BAR_WORDS 3456
#define XB_SPIN_CAP (1u << 18)
__device__ __forceinline__ unsigned xb_ld(unsigned* p)              { return __hip_atomic_load(p, __ATOMIC_RELAXED, __HIP_MEMORY_SCOPE_AGENT); }
__device__ __forceinline__ unsigned xb_add(unsigned* p, unsigned v) { return __hip_atomic_fetch_add(p, v, __ATOMIC_RELAXED, __HIP_MEMORY_SCOPE_AGENT); }
__device__ __forceinline__ unsigned xb_xcc_id() { return (unsigned)__builtin_amdgcn_s_getreg((3 << 11) | 20) & 0xFu; }
#define XB_SPIN(cond, bar) do { unsigned _sp = 0; while (cond) { __builtin_amdgcn_s_sleep(1); \
    if ((++_sp & 255u) == 0u) { if (xb_ld(&(bar)[XB_TMO])) break; if (_sp > XB_SPIN_CAP) { atomicAdd(&(bar)[XB_TMO], 1u); break; } } } } while (0)
__device__ __forceinline__ void xcd_barrier_complete(unsigned* bar, unsigned x, unsigned& nloc, unsigned& nx) {
    const unsigned G = gridDim.x * gridDim.y * gridDim.z;
    unsigned sum, cnt, mine, sp = 0u;
    for (;;) {
        sum = 0u; cnt = 0u; mine = 0u;
#pragma unroll
        for (unsigned j = 0; j < 16; ++j) { const unsigned c = xb_ld(&bar[XB_XCNT(j)]); sum += c; cnt += (c > 0u) ? 1u : 0u; mine = (j == x) ? c : mine; }
        if (sum == G) break;
        __builtin_amdgcn_s_sleep(1);
        if ((++sp & 255u) == 0u) { if (xb_ld(&bar[XB_TMO])) break; if (sp > XB_SPIN_CAP) { atomicAdd(&bar[XB_TMO], 1u); break; } }
    }
    nloc = mine > 0u ? mine : 1u; nx = cnt > 0u ? cnt : 1u;
}
__device__ __forceinline__ void xcd_barrier(unsigned* bar, volatile LAS unsigned* st) {
    asm volatile("s_waitcnt vmcnt(0)" ::: "memory");
    __syncthreads();
    if (threadIdx.x == 0) {
        __builtin_amdgcn_s_waitcnt(0);
        const unsigned x = st[0]; unsigned nloc = st[2], nx = st[3];
        if (nloc == 0u) { xcd_barrier_complete(bar, x, nloc, nx); st[2] = nloc; st[3] = nx; }
        const unsigned old = xb_add(&bar[XB_XSUB(x)], 1u);
        const unsigned gen = old / nloc;
        if (old + 1u == (gen + 1u) * nloc) {
            __builtin_amdgcn_fence(__ATOMIC_RELEASE, "agent");
            asm volatile("s_waitcnt vmcnt(0)" ::: "memory");
            const unsigned og = xb_add(&bar[XB_TOP], 1u);
            const unsigned tg = og / nx;
            if (og + 1u == (tg + 1u) * nx) xb_add(&bar[XB_TOPGEN], 1u);
            else XB_SPIN(xb_ld(&bar[XB_TOPGEN]) == tg, bar);
            __builtin_amdgcn_fence(__ATOMIC_ACQUIRE, "agent");
            xb_add(&bar[XB_XGEN(x)], 1u);
            asm volatile("s_waitcnt vmcnt(0)" ::: "memory");
        } else {
            XB_SPIN(xb_ld(&bar[XB_XGEN(x)]) == gen, bar);
            __builtin_amdgcn_fence(__ATOMIC_ACQUIRE, "agent");
            asm volatile("s_waitcnt vmcnt(0)" ::: "memory");
        }
    }
    __syncthreads();
}

#define XB2_XSUB(j) (3520 + 64 * (j))
#define XB2_XGEN(j) (4544 + 64 * (j))
__device__ __forceinline__ void xcd_local_barrier(unsigned* bar, volatile LAS unsigned* st) {
    asm volatile("s_waitcnt vmcnt(0)" ::: "memory");
    __syncthreads();
    if (threadIdx.x == 0) {
        __builtin_amdgcn_s_waitcnt(0);
        const unsigned x = st[0], nloc = st[2];
        const unsigned old = xb_add(&bar[XB2_XSUB(x)], 1u);
        const unsigned gen = old / nloc;
        if (old + 1u == (gen + 1u) * nloc) xb_add(&bar[XB2_XGEN(x)], 1u);
        else XB_SPIN(xb_ld(&bar[XB2_XGEN(x)]) == gen, bar);
        __builtin_amdgcn_fence(__ATOMIC_ACQUIRE, "agent");
        asm volatile("s_waitcnt vmcnt(0)" ::: "memory");
    }
    __syncthreads();
}

enum PhaseKind { K_PROA = 0, K_PROB, K_FFNIN, K_RESID, K_GV, K_SPATIAL, K_GU, K_QKV, K_TOPK, K_ATTSEL, K_ATTOWN, K_FINAL };
constexpr int NPHASE = 20;

__device__ __forceinline__ void rstd_prepass(LAS float* rst, const float* sumsq, int g8, int tid, int pm1, float mul = 1.0f) {
    if (pm1 >= 0) {
        if (tid < 256) { const f32x4* p = (const f32x4*)(sumsq + (size_t)(pm1 * 256 + tid) * 16); const f32x4 a = p[0], b = p[1], c = p[2], d = p[3];
            const float s = ((a.x + a.y) + (a.z + a.w)) + ((b.x + b.y) + (b.z + b.w)) + ((c.x + c.y) + (c.z + c.w)) + ((d.x + d.y) + (d.z + d.w));
            rst[(pm1 & 7) * 256 + tid] = rsqrtf(s * (1.0f / DM) + RMS_EPS) * mul; }
        return;
    }
    f32x4 v[4][4];
#pragma unroll
    for (int k = 0; k < 4; ++k) { const f32x4* p = (const f32x4*)(sumsq + (size_t)(g8 * 2048 + tid + 512 * k) * 16);
#pragma unroll
        for (int j = 0; j < 4; ++j) v[k][j] = p[j]; }
#pragma unroll
    for (int k = 0; k < 4; ++k) { float s = 0.f;
#pragma unroll
        for (int j = 0; j < 4; ++j) s += (v[k][j].x + v[k][j].y) + (v[k][j].z + v[k][j].w);
        rst[tid + 512 * k] = rsqrtf(s * (1.0f / DM) + RMS_EPS) * mul; }
}

__device__ __forceinline__ void bias_prepass(LAS float* bl, const float* bpart, int N, int coloff, bool ffn, const pg8::StaticOrder& S, int tid) {
    const int j = tid & 255, i0 = __builtin_amdgcn_readfirstlane(tid >> 8);
    float v[3][16]; bool ok[3];
#pragma unroll
    for (int q = 0; q < 3; ++q) { pg8::Unit u; ok[q] = S.next(i0 + 2 * q, u);
        const int n = ok[q] ? (ffn ? (j < 128 ? u.pn * 128 + j : DFF + u.pn * 128 + (j - 128)) : coloff + u.pn * 256 + j) : 0;
#pragma unroll
        for (int kb = 0; kb < 16; ++kb) v[q][kb] = bpart[(size_t)kb * N + n]; }
#pragma unroll
    for (int q = 0; q < 3; ++q) { float s = 0.f;
#pragma unroll
        for (int kb = 0; kb < 16; ++kb) s += v[q][kb];
        if (ok[q]) bl[(i0 + 2 * q) * 256 + j] = s; }
    __syncthreads();
}

__device__ __forceinline__ void phase_proa(const Args& args, unsigned char* ws, LAS unsigned char* lds, int tid, int lane, int wave, int G, int bx, int vcu) {
    float* mod = (float*)(ws + WS_MOD);
    LAS f32x4* red = (LAS f32x4*)lds;
    for (int it = bx; it < 144; it += G) {
        const int layer = it / 72, n0 = (it % 72) * 128;
        colsum_item<true>(args.in[IN_MODW] + (size_t)layer * DM * 9216, 9216, n0, args.in[IN_C], args.in[IN_MODB] + layer * 9216, mod + layer * 9216, red, tid);
    }
    __syncthreads();
    LAS float* scr = (LAS float*)(lds + wave * 16384);
    const int gw = vcu * NWAVES + wave, NGW = G * NWAVES;
    constexpr int I_FOUT = (DFF / 64) * (DM / 32), I_GOUT = (GMD / 64) * (DM / 32);
    constexpr int NITEMS = I_FOUT + I_GOUT;
    for (int it = gw; it < NITEMS; it += NGW) {
        int r = it;
        if (r < I_FOUT) { transpose_item(args.in[IN_FWOUT], DFF, DM, (bf16_t*)(ws + W0_FOUT), 0, scr, r, lane, nullptr, nullptr, nullptr, nullptr, F8_OUT ? F8_WSCALE : 0.f); continue; }
        r -= I_FOUT;
        transpose_item(args.in[IN_GWOUT], GMD, DM, (bf16_t*)(ws + W0_GOUT), 0, scr, r, lane);
    }
}
__device__ __forceinline__ void convert_outs(const Args& args, unsigned char* ws, LAS unsigned char* lds, int lane, int wave, int gw, int NGW, int omask) {
    const float* mod = (const float*)(ws + WS_MOD); const float* ngp = args.in[IN_NORMG]; float* bpart = (float*)(ws + WS_BPART);
    LAS float* scr = (LAS float*)(lds + wave * 16384);
    constexpr int I_FOUT = (DFF / 64) * (DM / 32), I_QKV = (DM / 64) * (3072 / 32), I_WO = (DM / 64) * (DM / 32);
    const int n0 = (omask & 1) ? I_FOUT : 0, n1 = (omask & 2) ? I_FOUT : 0, n2 = (omask & 4) ? I_FOUT : 0, n3 = (omask & 8) ? I_QKV : 0, n4 = (omask & 16) ? I_WO : 0;
    for (int it = gw; it < n0 + n1 + n2 + n3 + n4; it += NGW) {
        int r = it;
        if (r < n0 + n1 + n2) { const int w = r < n0 ? 1 : (r < n0 + n1 ? 2 : 3); r -= r < n0 ? 0 : (r < n0 + n1 ? n0 : n0 + n1);
            transpose_item(args.in[IN_FWOUT] + (size_t)w * DFF * DM, DFF, DM, (bf16_t*)(ws + ((w >> 1) ? W1_FOUT : W0_FOUT) + (size_t)(w & 1) * SZ_FOUT), 0, scr, r, lane, nullptr, nullptr, nullptr, nullptr, F8_OUT ? F8_WSCALE : 0.f); continue; }
        r -= n0 + n1 + n2;
        if (r < n3) { transpose_item(args.in[IN_WQKV], DM, 3072, (bf16_t*)(ws + W1_QKV), 0, scr, r, lane, ngp + (3 + 1) * DM, mod + 9216 + (1 * 3 + 1) * DM, mod + 9216 + (1 * 3 + 0) * DM, bpart + BP_Q); continue; }
        r -= n3;
        transpose_item(args.in[IN_WO], DM, DM, (bf16_t*)(ws + W1_WO), 0, scr, r, lane);
    }
}
__device__ __forceinline__ void deferred_convert(const Args& args, unsigned char* ws, LAS unsigned char* lds, int lane, int wave, int rank, int nidle, int stage, int part) {
    const float* mod = (const float*)(ws + WS_MOD); const float* ngp = args.in[IN_NORMG]; float* bpart = (float*)(ws + WS_BPART);
    LAS float* scr = (LAS float*)(lds + wave * 16384);
    const int gw = rank * NWAVES + wave, NGW = nidle * NWAVES;
    constexpr int I_FIN = (DM / 64) * (NFF2 / 32), I_FOUT = (DFF / 64) * (DM / 32), I_QKV = (DM / 64) * (3072 / 32), I_WO = (DM / 64) * (DM / 32);
    const int w = 2 + stage, sub = stage ? 2 : 0;
    const int nitems = I_FIN + I_FOUT + (stage == 0 ? I_FIN + I_FOUT : I_QKV + I_WO);
    const int it_lo = part == 2 ? I_FIN + I_FOUT : 0, it_hi = part == 1 ? I_FIN + I_FOUT : nitems;
    for (int it = it_lo + gw; it < it_hi; it += NGW) {
        int r = it;
        if (r < I_FIN) { if (!((I8_IN >> w) & 1)) transpose_item(args.in[IN_FWIN] + (size_t)w * DM * NFF2, DM, NFF2, (bf16_t*)(ws + W1_FIN + (size_t)stage * SZ_FIN), 1, scr, r, lane, ngp + (3 + sub) * DM, mod + 9216 + (sub * 3 + 1) * DM, mod + 9216 + (sub * 3 + 0) * DM, bpart + BP_F + w * 16 * NFF2, ((F8_IN17 && stage == 1) || (F8_IN10 && stage == 0)) ? F8_INSCALE : 0.f); continue; }
        r -= I_FIN;
        if (r < I_FOUT) { transpose_item(args.in[IN_FWOUT] + (size_t)w * DFF * DM, DFF, DM, (bf16_t*)(ws + W1_FOUT + (size_t)stage * SZ_FOUT), 0, scr, r, lane, nullptr, nullptr, nullptr, nullptr, F8_OUT ? F8_WSCALE : 0.f); continue; }
        r -= I_FOUT;
        if (stage == 0) {
            if (r < I_FIN) { if (!(I8_IN & 2)) transpose_item(args.in[IN_FWIN] + (size_t)1 * DM * NFF2, DM, NFF2, (bf16_t*)(ws + W0_FIN + SZ_FIN), 1, scr, r, lane, ngp + 2 * DM, mod + (2 * 3 + 1) * DM, mod + (2 * 3 + 0) * DM, bpart + BP_F + 1 * 16 * NFF2); continue; }
            r -= I_FIN;
            transpose_item(args.in[IN_FWOUT] + (size_t)1 * DFF * DM, DFF, DM, (bf16_t*)(ws + W0_FOUT + SZ_FOUT), 0, scr, r, lane, nullptr, nullptr, nullptr, nullptr, F8_OUT ? F8_WSCALE : 0.f);
        } else {
            if (r < I_QKV) { transpose_item(args.in[IN_WQKV], DM, 3072, (bf16_t*)(ws + W1_QKV), 0, scr, r, lane, ngp + (3 + 1) * DM, mod + 9216 + (1 * 3 + 1) * DM, mod + 9216 + (1 * 3 + 0) * DM, bpart + BP_Q); continue; }
            r -= I_QKV;
            transpose_item(args.in[IN_WO], DM, DM, (bf16_t*)(ws + W1_WO), 0, scr, r, lane);
        }
    }
}

__device__ __forceinline__ void phase_prob(const Args& args, unsigned char* ws, LAS unsigned char* lds, int tid, int lane, int wave, int G, int bx, int vcu) {
    float* mod = (float*)(ws + WS_MOD);
    float* bpart = (float*)(ws + WS_BPART);
    float* tab = (float*)(ws + WS_TAB); float* sumsq = (float*)(ws + WS_SUMSQ); bf16_t* xb = (bf16_t*)(ws + WS_XB);
    const int gt = bx * NTHREADS + tid, NT = G * NTHREADS;
    for (int i = gt; i < 6 * DM; i += NT) { const int ls = i / DM, k = i % DM, layer = ls / 3, sub = ls % 3;
        ((float*)(ws + WS_GATE))[i] = mod[layer * 9216 + (sub * 3 + 2) * DM + k] * (sub == 1 ? 1.0f : (F8_OUT ? 0.5f / F8_WSCALE : 0.5f)); }
    for (int i = gt; i < NH * 128; i += NT) { const int h = i >> 7, n = i & 127; int b;
        if (n < 16) b = n; else { b = 16 + (int)(logf((float)n / 16.0f) / 2.0794415416798357f * 16.0f); b = b > 31 ? 31 : b; }
        tab[i] = args.in[IN_RELB][b * NH + h] * LOG2E; }
    const int gw = vcu * NWAVES + wave, NGW = G * NWAVES;
    {
        LAS float* scr = (LAS float*)(lds + wave * 16384);
        const float* ngp = args.in[IN_NORMG];
        constexpr int I_FIN = (DM / 64) * (NFF2 / 32), I_GIN = (DM / 64) * (6144 / 32);
        constexpr int NITEMS = I_FIN + I_GIN;
        static_assert(I8_IN == 0xF, "the conversion plan below assumes int8 for all four FFN-in matrices");
        for (int it = vcu; it < 2 * (NFF2 / 32); it += G) { const int wq = it >= NFF2 / 32 ? 2 : 0, nb = it - (wq ? NFF2 / 32 : 0), lay = wq >> 1;
            convert_i8_item(args.in[IN_FWIN] + (size_t)wq * DM * NFF2, NFF2, ws + (lay ? W1_FIN : W0_FIN), scr, (LAS float*)(lds + RING_BYTES), nb, lane, wave,
                            ngp + (lay * 3) * DM, mod + lay * 9216 + (0 * 3 + 1) * DM, mod + lay * 9216 + (0 * 3 + 0) * DM, bpart + BP_F + wq * 16 * NFF2, (float*)(ws + WS_CS) + wq * NFF2); }
        if (I8_GIN) for (int it = vcu; it < 6144 / 32; it += G)
            convert_i8_item(args.in[IN_GWIN], 6144, ws + W0_GIN, scr, (LAS float*)(lds + RING_BYTES), it, lane, wave, ngp + (0 * 3 + 1) * DM, mod + 0 * 9216 + (1 * 3 + 1) * DM, mod + 0 * 9216 + (1 * 3 + 0) * DM, bpart + BP_G, (float*)(ws + WS_CS) + 4 * NFF2, 0);
        __syncthreads();
        convert_outs(args, ws, lds, lane, wave, gw, NGW, 1 | 2);
        for (int it = gw; it < NITEMS; it += NGW) {
            int r = it;
            if (r < I_FIN) { if (!(I8_IN & 1)) transpose_item(args.in[IN_FWIN], DM, NFF2, (bf16_t*)(ws + W0_FIN), 1, scr, r, lane, ngp, mod + (0 * 3 + 1) * DM, mod + (0 * 3 + 0) * DM, bpart + BP_F); continue; }
            r -= I_FIN;
            if (!I8_GIN) transpose_item(args.in[IN_GWIN], DM, 6144, (bf16_t*)(ws + W0_GIN), 0, scr, r, lane, ngp + (0 * 3 + 1) * DM, mod + 0 * 9216 + (1 * 3 + 1) * DM, mod + 0 * 9216 + (1 * 3 + 0) * DM, bpart + BP_G);
        }
    }
    const float* x = args.in[IN_X];
    for (int m0 = gw * 4; m0 < SEQ; m0 += NGW * 4) {
        f32x4 v[4][4];
#pragma unroll
        for (int r = 0; r < 4; ++r) { const f32x4* xr = (const f32x4*)(x + (size_t)(m0 + r) * DM) + lane;
#pragma unroll
            for (int j = 0; j < 4; ++j) v[r][j] = xr[64 * j]; }
#pragma unroll
        for (int r = 0; r < 4; ++r) { float s = 0.f;
#pragma unroll
            for (int j = 0; j < 4; ++j) s += (v[r][j].x * v[r][j].x + v[r][j].y * v[r][j].y) + (v[r][j].z * v[r][j].z + v[r][j].w * v[r][j].w);
            s = wave_sum(s);
            u32x2* o8 = (u32x2*)(xb + (size_t)(m0 + r) * DM) + lane;
#pragma unroll
            for (int j = 0; j < 4; ++j) { u32x2 w; w.x = cvt_pk_bf16(v[r][j].x, v[r][j].y); w.y = cvt_pk_bf16(v[r][j].z, v[r][j].w); o8[64 * j] = w; }
            if (I8_IN & 1) { unsigned* o1 = (unsigned*)(ws + WS_X8 + (size_t)(m0 + r) * DM) + lane; constexpr float QX = 127.0f / I8_XCLIP;
#pragma unroll
                for (int j = 0; j < 4; ++j) o1[64 * j] = pk4_i8(v[r][j].x * QX, v[r][j].y * QX, v[r][j].z * QX, v[r][j].w * QX); }
            if (lane < 16) sumsq[(size_t)(m0 + r) * 16 + lane] = lane == 0 ? s : 0.f; }
    }
}

__device__ __forceinline__ void phase_spatial(const Args& args, unsigned char* ws, LAS unsigned char* lds, int tid, int lane, int wave, int G, int vcu, bool nostore) {
    const float* vsq = (const float*)(ws + WS_VSQ); bf16_t* zv = (bf16_t*)(ws + WS_ZV);
    const float* wsp = args.in[IN_GWS]; const float* bsp = args.in[IN_GBS]; const float* vnp = args.in[IN_GVN];
    LAS float* rsd = (LAS float*)lds;
    LAS unsigned char* Wimg = lds + 1024;
    LAS unsigned char* Vimg = lds + 36864;
    constexpr int VST = 72, VSL = 128 * VST;
    const int nit_sp = (G == 256) ? 8 : (128 * 16 + G - 1 - vcu) / G;
#define SP_ITEM(K) ((G == 256) ? (vcu >> 5) * 256 + (vcu & 31) + 32 * (K) : vcu + (K) * G)
#define SP_LOAD(V, RS, IT) do { const int c_ = (IT) >> 4, g_ = (IT) & 15; \
        _Pragma("unroll") for (int i = 0; i < 6; ++i) { const int cidx = tid + 512 * i, row = cidx / 24, ch = cidx % 24; V[i] = *(const u32x4*)(zv + (size_t)(c_ * 128 + row) * GMD + g_ * 192 + ch * 8); } \
        if (tid < 128) { const f32x4* pp = (const f32x4*)(vsq + (size_t)(c_ * 128 + tid) * 48); float s = 0.f; \
            _Pragma("unroll") for (int j = 0; j < 12; ++j) { const f32x4 a = pp[j]; s += (a.x + a.y) + (a.z + a.w); } RS = rsqrtf(s * (1.0f / GMD) + RMS_EPS); } } while (0)
    u32x4 vcur[6]; float rs_cur = 0.f; f32x4 wreg[4][2]; int g_loaded = -1;
    if (nit_sp > 0) SP_LOAD(vcur, rs_cur, SP_ITEM(0));
    for (int k_sp = 0; k_sp < nit_sp; ++k_sp) {
        const int it = SP_ITEM(k_sp);
        const int c = it >> 4, g = it & 15;
        __syncthreads();
        if (tid < 128) rsd[tid] = rs_cur;
#pragma unroll
        for (int i = 0; i < 6; ++i) { const int cidx = tid + 512 * i, row = cidx / 24, ch = cidx % 24, w = ch >> 2, c4 = ch & 3;
            LAS u32x2* d = (LAS u32x2*)(Vimg + w * VSL + row * VST + c4 * 16); d[0] = (u32x2){vcur[i].x, vcur[i].y}; d[1] = (u32x2){vcur[i].z, vcur[i].w}; }
        u32x4 vnext[6]; float rs_next = 0.f;
        if (k_sp + 1 < nit_sp) SP_LOAD(vnext, rs_next, SP_ITEM(k_sp + 1));
        else {
#pragma unroll
            for (int i = 0; i < 6; ++i) vnext[i] = vcur[i]; }
        __syncthreads();
        if (g != g_loaded) {
#pragma unroll
            for (int i = 0; i < 4; ++i) { const int cidx = tid + 512 * i, t = cidx >> 4, s0 = (cidx & 15) * 8; const float* wrow = wsp + ((size_t)g * 128 + t) * 128 + s0;
                wreg[i][0] = *(const f32x4*)wrow; wreg[i][1] = *(const f32x4*)(wrow + 4); }
            g_loaded = g;
        }
#pragma unroll
        for (int i = 0; i < 4; ++i) { const int cidx = tid + 512 * i, t = cidx >> 4, s0 = (cidx & 15) * 8;
            const f32x4 w0 = wreg[i][0], w1 = wreg[i][1];
            float a[8];
#pragma unroll
            for (int j = 0; j < 4; ++j) { a[j] = (s0 + j <= t) ? w0[j] * rsd[s0 + j] : 0.f; a[4 + j] = (s0 + 4 + j <= t) ? w1[j] * rsd[s0 + 4 + j] : 0.f; }
            u32x4 aw; aw.x = cvt_pk_bf16(a[0], a[1]); aw.y = cvt_pk_bf16(a[2], a[3]); aw.z = cvt_pk_bf16(a[4], a[5]); aw.w = cvt_pk_bf16(a[6], a[7]);
            *(LAS u32x4*)(Wimg + t * 272 + s0 * 2) = aw; }
        __syncthreads();
        if (wave < 6) {
            const int r32 = lane & 31, hf = lane >> 5, g16 = lane >> 4, i16 = lane & 15, q = i16 >> 2, pp = i16 & 3;
            LAS unsigned char* slice = Vimg + wave * VSL;
            const LAS unsigned char* vb = slice + (8 * hf + q) * VST + (16 * (g16 & 1) + 4 * pp) * 2;
            bf16x8 af[8];
#pragma unroll
            for (int ks = 0; ks < 8; ++ks) {
                const v4i16_t lo = __builtin_amdgcn_ds_read_tr16_b64_v4i16((LAS v4i16_t*)(vb + ks * 16 * VST));
                const v4i16_t hi = __builtin_amdgcn_ds_read_tr16_b64_v4i16((LAS v4i16_t*)(vb + ks * 16 * VST + 4 * VST));
                af[ks] = (bf16x8){lo[0], lo[1], lo[2], lo[3], hi[0], hi[1], hi[2], hi[3]};
            }
            f32x16 acc[4];
#pragma unroll
            for (int i = 0; i < 4; ++i) {
                acc[i] = (f32x16){};
                const LAS unsigned char* wr_ = Wimg + (32 * i + r32) * 272 + 16 * hf;
#pragma unroll
                for (int ks = 0; ks < 2 * i + 2; ++ks) {
                    const bf16x8 bfrag = *(const LAS bf16x8*)(wr_ + 32 * ks);
                    acc[i] = __builtin_amdgcn_mfma_f32_32x32x16_bf16(af[ks], bfrag, acc[i], 0, 0, 0);
                }
            }
            f32x4 vn4[4];
#pragma unroll
            for (int g4 = 0; g4 < 4; ++g4) vn4[g4] = *(const f32x4*)(vnp + g * 192 + wave * 32 + 8 * g4 + 4 * hf);
#pragma unroll
            for (int i = 0; i < 4; ++i) {
                const float bsv = bsp[g * 128 + 32 * i + r32];
#pragma unroll
                for (int g4 = 0; g4 < 4; ++g4) {
                    const float v0 = acc[i][4 * g4] * vn4[g4][0] + bsv, v1 = acc[i][4 * g4 + 1] * vn4[g4][1] + bsv, v2 = acc[i][4 * g4 + 2] * vn4[g4][2] + bsv, v3 = acc[i][4 * g4 + 3] * vn4[g4][3] + bsv;
                    u32x2 w; w.x = cvt_pk_bf16(v0, v1); w.y = cvt_pk_bf16(v2, v3);
                    *(LAS u32x2*)(slice + (32 * i + r32) * VST + (8 * g4 + 4 * hf) * 2) = w;
                }
            }
        }
        __syncthreads();
#pragma unroll
        for (int i = 0; i < 6; ++i) { const int cidx = tid + 512 * i, row = cidx / 24, ch = cidx % 24, w = ch >> 2, c4 = ch & 3;
            const LAS u32x2* d = (const LAS u32x2*)(Vimg + w * VSL + row * VST + c4 * 16); const u32x2 a = d[0], b = d[1];
            if (!nostore) st16(zv + (size_t)(c * 128 + row) * GMD + g * 192 + ch * 8, (u32x4){a.x, a.y, b.x, b.y}); }
#pragma unroll
        for (int i = 0; i < 6; ++i) vcur[i] = vnext[i];
        rs_cur = rs_next;
    }
#undef SP_ITEM
#undef SP_LOAD
}

__device__ __forceinline__ void phase_topk(unsigned char* ws, LAS unsigned char* lds, int tid, int lane, int wave, int G, int vcu, bool nostore) {
    const float* ksum = (const float*)(ws + WS_KSUM); unsigned* cnt = (unsigned*)(ws + WS_CTL);
    unsigned short* lists = (unsigned short*)(ws + AT_LIST); const bf16_t* qh = (const bf16_t*)(ws + AT_Q);
    LAS unsigned* lcnt = (LAS unsigned*)lds;
    LAS unsigned* lbase = (LAS unsigned*)(lds + 1024);
    const int r32 = lane & 31, hf = lane >> 5;
    const int nper = (NH * 64 + G - 1) / G;
    bf16x8 khi[2][4], klo[2][4]; int h_loaded = -1;
    for (int kb = 0; kb < nper; kb += 4) {
        __syncthreads();
        if (tid < 256) lcnt[tid] = 0u;
        __syncthreads();
        int pi0[4], pi1[4], pi2[4], pt[4], pns[4], phh[4]; unsigned prk0[4], prk1[4], prk2[4];
#pragma unroll
        for (int j = 0; j < 4; ++j) {
            const int it = vcu * nper + kb + j; const bool on = kb + j < nper && it < NH * 64 && (it & 63) != 0;
            const int h = it >> 6, jb = it & 63;
            pns[j] = 0; phh[j] = on ? h : 0; pi0[j] = 0; pi1[j] = 0; pi2[j] = 0; pt[j] = 0; prk0[j] = 0u; prk1[j] = 0u; prk2[j] = 0u;
            if (on) {
                if (h != h_loaded) {
#pragma unroll
                    for (int nt = 0; nt < 2; ++nt) {
                        const float* k0 = ksum + ((size_t)(32 * nt + r32) * 2) * DM + h * HD + 8 * hf;
#pragma unroll
                        for (int ds = 0; ds < 4; ++ds) {
                            const f32x4 a0 = *(const f32x4*)(k0 + 16 * ds), a1 = *(const f32x4*)(k0 + 16 * ds + 4), b0 = *(const f32x4*)(k0 + DM + 16 * ds), b1 = *(const f32x4*)(k0 + DM + 16 * ds + 4);
                            const f32x4 x0 = a0 + b0, x1 = a1 + b1;
                            u32x4 hi; hi.x = cvt_pk_bf16(x0[0], x0[1]); hi.y = cvt_pk_bf16(x0[2], x0[3]); hi.z = cvt_pk_bf16(x1[0], x1[1]); hi.w = cvt_pk_bf16(x1[2], x1[3]);
                            u32x4 lo; lo.x = cvt_pk_bf16(x0[0] - bf_lo(hi.x), x0[1] - bf_hi(hi.x)); lo.y = cvt_pk_bf16(x0[2] - bf_lo(hi.y), x0[3] - bf_hi(hi.y));
                            lo.z = cvt_pk_bf16(x1[0] - bf_lo(hi.z), x1[1] - bf_hi(hi.z)); lo.w = cvt_pk_bf16(x1[2] - bf_lo(hi.w), x1[3] - bf_hi(hi.w));
                            khi[nt][ds] = __builtin_bit_cast(bf16x8, hi); klo[nt][ds] = __builtin_bit_cast(bf16x8, lo);
                        }
                    }
                    h_loaded = h;
                }
                const int t = jb * 256 + wave * 32 + r32;
                bf16x8 qf[4];
#pragma unroll
                for (int ds = 0; ds < 4; ++ds) qf[ds] = *(const bf16x8*)(qh + ((size_t)h * SEQ + t) * HD + 16 * ds + 8 * hf);
                f32x16 sc[2];
#pragma unroll
                for (int nt = 0; nt < 2; ++nt) {
                    sc[nt] = (f32x16){};
                    if (32 * nt < jb) {
#pragma unroll
                        for (int ds = 0; ds < 4; ++ds) {
                            sc[nt] = __builtin_amdgcn_mfma_f32_32x32x16_bf16(khi[nt][ds], qf[ds], sc[nt], 0, 0, 0);
                            sc[nt] = __builtin_amdgcn_mfma_f32_32x32x16_bf16(klo[nt][ds], qf[ds], sc[nt], 0, 0, 0);
                        }
                    }
                }
                int ka = (int)0x80000000, kb_ = (int)0x80000000, kc = (int)0x80000000;
#define TK_INS(X) do { const int x_ = (X); const int t1_ = x_ < ka ? x_ : ka; ka = x_ > ka ? x_ : ka; const int t2_ = t1_ < kb_ ? t1_ : kb_; kb_ = t1_ > kb_ ? t1_ : kb_; kc = t2_ > kc ? t2_ : kc; } while (0)
#pragma unroll
                for (int nt = 0; nt < 2; ++nt)
#pragma unroll
                    for (int r = 0; r < 16; ++r) {
                        const int n = 32 * nt + (r & 3) + 8 * (r >> 2) + 4 * hf;
                        const int bits = __float_as_int(sc[nt][r]); const int mono = bits ^ (int)((unsigned)(bits >> 31) >> 1);
                        const int key = n < jb ? ((mono & ~63) | (63 - n)) : (int)0x80000000;
                        TK_INS(key);
                    }
                { const int pa = __shfl_xor(ka, 32), pb2 = __shfl_xor(kb_, 32), pc = __shfl_xor(kc, 32); TK_INS(pa); TK_INS(pb2); TK_INS(pc); }
#undef TK_INS
                const int i0 = 63 - (ka & 63), i1 = 63 - (kb_ & 63), i2 = 63 - (kc & 63);
                const int nsel = jb < 3 ? jb : 3; const bool act = hf == 0;
                LAS unsigned* lc = lcnt + j * 64;
                if (act && nsel > 0) prk0[j] = atomicAdd((unsigned*)&lc[i0], 1u);
                if (act && nsel > 1) prk1[j] = atomicAdd((unsigned*)&lc[i1], 1u);
                if (act && nsel > 2) prk2[j] = atomicAdd((unsigned*)&lc[i2], 1u);
                pns[j] = act ? nsel : 0; pi0[j] = i0; pi1[j] = i1; pi2[j] = i2; pt[j] = t;
            }
        }
        __syncthreads();
        if (tid < 256) { const int j = tid >> 6, n = tid & 63; const int hj = j == 0 ? phh[0] : (j == 1 ? phh[1] : (j == 2 ? phh[2] : phh[3]));
            const unsigned cc = lcnt[tid]; lbase[tid] = (cc && !nostore) ? atomicAdd(&cnt[hj * 64 + n], cc) : 0u; }
        __syncthreads();
        if (!nostore) {
#pragma unroll
            for (int j = 0; j < 4; ++j) { const LAS unsigned* lb = lbase + j * 64;
                if (pns[j] > 0) lists[list_base(phh[j], pi0[j]) + lb[pi0[j]] + prk0[j]] = (unsigned short)((pt[j] << 2) | 0);
                if (pns[j] > 1) lists[list_base(phh[j], pi1[j]) + lb[pi1[j]] + prk1[j]] = (unsigned short)((pt[j] << 2) | 1);
                if (pns[j] > 2) lists[list_base(phh[j], pi2[j]) + lb[pi2[j]] + prk2[j]] = (unsigned short)((pt[j] << 2) | 2); }
        }
    }
}

__device__ __forceinline__ void attsel_locate(const LAS unsigned* pre, int item, int& li, int& ci) {
    int lo = 0, hi = 1023;
    while (lo < hi) { const int mid = (lo + hi + 1) >> 1; if ((int)pre[mid] <= item) lo = mid; else hi = mid - 1; }
    li = lo; ci = item - (int)pre[lo];
}
__device__ __forceinline__ void load_q4(bf16x8 (&qf)[4], const bf16_t* qrow, int hf) {
#pragma unroll
    for (int ds = 0; ds < 4; ++ds) qf[ds] = *(const bf16x8*)(qrow + 16 * ds + 8 * hf);
}
__device__ __forceinline__ void phase_attsel(unsigned char* ws, LAS unsigned char* lds, int tid, int lane, int wave, int G, int vcu, bool dup) {
    const unsigned* cnt = (const unsigned*)(ws + WS_CTL); const float* tab = (const float*)(ws + WS_TAB);
    const unsigned short* lists = (const unsigned short*)(ws + AT_LIST); f32x2* pml = (f32x2*)(ws + AT_ML);
    const bf16_t* qh = (const bf16_t*)(ws + AT_Q); const bf16_t* kh = (const bf16_t*)(ws + AT_K); const bf16_t* vh = (const bf16_t*)(ws + AT_V); bf16_t* po = (bf16_t*)(ws + AT_PO);
    LAS unsigned* pre = (LAS unsigned*)(lds + RING_BYTES);
    LAS unsigned short* cn16 = (LAS unsigned short*)(lds + RING_BYTES + 4224);
    LAS float* tabl = (LAS float*)(lds + RING_BYTES + 8448);
    __syncthreads();
    for (int i = tid; i < 1024; i += NTHREADS) { const unsigned c = cnt[i]; pre[i + 1] = (c + 255u) >> 8; cn16[i] = (unsigned short)c; }
    if (tid == 0) pre[0] = 0u;
    __syncthreads();
    if (tid < 64) {
        unsigned v[16]; unsigned s = 0;
#pragma unroll
        for (int i = 0; i < 16; ++i) { v[i] = pre[1 + tid * 16 + i]; s += v[i]; }
        unsigned inc = s;
#pragma unroll
        for (int o = 1; o < 64; o <<= 1) { const unsigned y = __shfl_up(inc, o); if (lane >= o) inc += y; }
        unsigned run = inc - s;
#pragma unroll
        for (int i = 0; i < 16; ++i) { run += v[i]; pre[1 + tid * 16 + i] = run; }
    }
    __syncthreads();
    const int total = (int)pre[1024];
    const int r32 = lane & 31, hf = lane >> 5;
    const int q_per = (total + G - 1) / G, g0 = vcu * q_per, g1 = (g0 + q_per < total) ? g0 + q_per : total;
    if (g0 >= g1) return;
    int g = g0, li = 0, ci = 0, b = 0;
    bool have_pre = false; unsigned pre_e0 = 0u, pre_e1 = 0u; bf16x8 pre_q[4] = {};
    attsel_locate(pre, g, li, ci);
    { const int h = li >> 6, n = li & 63;
      if (tid < 129) tabl[tid] = tid < 128 ? tab[h * 128 + tid] - tab[h * 128 + 127] : tab[h * 128 + 127];
      dma_kv(lds, kh + ((size_t)h * SEQ + n * 256) * HD, vh + ((size_t)h * SEQ + n * 256) * HD, tid, wave); }
#define ATS_ENTRY(CI) lists[lbase_ + ((CI) * 256 + wave * 32 + r32 < cn ? (CI) * 256 + wave * 32 + r32 : (CI) * 256 + wave * 32)]
    while (g < g1) {
        const int h = li >> 6, n = li & 63, cn = (int)cn16[li];
        const int c0 = g - (int)pre[li], nch = (int)pre[li + 1] - (int)pre[li], c1 = (c0 + (g1 - g) < nch) ? c0 + (g1 - g) : nch;
        const int gn = g + (c1 - c0); int lin = li + 1;
        if (gn < g1) { while (lin < 1023 && pre[lin + 1] == pre[lin]) ++lin;
            const int h2 = lin >> 6, n2 = lin & 63;
            if (tid < 129) tabl[(b ^ 1) * 132 + tid] = tid < 128 ? tab[h2 * 128 + tid] - tab[h2 * 128 + 127] : tab[h2 * 128 + 127];
            dma_kv(lds + (b ^ 1) * 65536, kh + ((size_t)h2 * SEQ + n2 * 256) * HD, vh + ((size_t)h2 * SEQ + n2 * 256) * HD, tid, wave);
            asm volatile("s_waitcnt vmcnt(8)" ::: "memory"); }
        else asm volatile("s_waitcnt vmcnt(0)" ::: "memory");
        asm volatile("s_waitcnt lgkmcnt(0)" ::: "memory"); __builtin_amdgcn_s_barrier(); asm volatile("" ::: "memory");
        const int lbase_ = list_base(h, n);
        if (c0 * 256 + wave * 32 < cn) {
            unsigned e_cur, e_nxt = 0u; bf16x8 qf[4];
            if (have_pre) { e_cur = pre_e0; e_nxt = pre_e1;
#pragma unroll
                for (int ds = 0; ds < 4; ++ds) qf[ds] = pre_q[ds]; }
            else { e_cur = ATS_ENTRY(c0);
                if (c0 + 1 < c1 && (c0 + 1) * 256 + wave * 32 < cn) e_nxt = ATS_ENTRY(c0 + 1);
                load_q4(qf, qh + ((size_t)h * SEQ + (e_cur >> 2)) * HD, hf); }
            for (int c = c0; c < c1; ++c) {
                const int e0 = c * 256 + wave * 32;
                if (e0 >= cn) break;
                const bool has1 = c + 1 < c1 && e0 + 256 < cn, has2 = c + 2 < c1 && e0 + 512 < cn;
                unsigned e_n2 = 0u; bf16x8 qn[4] = {};
                if (has2) e_n2 = ATS_ENTRY(c + 2);
                if (has1) load_q4(qn, qh + ((size_t)h * SEQ + (e_nxt >> 2)) * HD, hf);
                const bool valid = e0 + r32 < cn; const int t = (int)(e_cur >> 2), slot = (int)(e_cur & 3u);
                float m, l; f32x16 o[2];
                if (!(dup && (PROBE_ATT & 1))) attn_tile<0>(qf, lds + b * 65536, lds + b * 65536 + 32768, tabl + b * 132, n * 256, 8, t, lane, m, l, o); else { m = 0.f; l = 1.f; o[0] = (f32x16){}; o[1] = (f32x16){}; }
                if (valid && !(dup && (PROBE_ATT & 2))) {
                    const float inv = fast_rcp(l); const size_t pe = ((size_t)h * SEQ + t) * 3 + slot;
                    bf16_t* op = po + pe * HD + 32 * hf;
#pragma unroll
                    for (int dt = 0; dt < 2; ++dt)
#pragma unroll
                        for (int gp = 0; gp < 2; ++gp) {
                            if (PO8) { u32x2 w8; w8.x = pk4_fp8(o[dt][8 * gp] * inv, o[dt][8 * gp + 1] * inv, o[dt][8 * gp + 2] * inv, o[dt][8 * gp + 3] * inv); w8.y = pk4_fp8(o[dt][8 * gp + 4] * inv, o[dt][8 * gp + 5] * inv, o[dt][8 * gp + 6] * inv, o[dt][8 * gp + 7] * inv);
                                st8((unsigned char*)po + (size_t)pe * HD + 32 * hf + 16 * dt + 8 * gp, w8); continue; }
                            u32x4 w; w.x = cvt_pk_bf16(o[dt][8 * gp] * inv, o[dt][8 * gp + 1] * inv); w.y = cvt_pk_bf16(o[dt][8 * gp + 2] * inv, o[dt][8 * gp + 3] * inv);
                            w.z = cvt_pk_bf16(o[dt][8 * gp + 4] * inv, o[dt][8 * gp + 5] * inv); w.w = cvt_pk_bf16(o[dt][8 * gp + 6] * inv, o[dt][8 * gp + 7] * inv);
                            st16(op + 16 * dt + 8 * gp, w); }
                    if (hf == 0) pml[pe] = (f32x2){m, l};
                }
                e_cur = e_nxt; e_nxt = e_n2;
#pragma unroll
                for (int ds = 0; ds < 4; ++ds) qf[ds] = qn[ds];
            }
        }
        have_pre = false;
        if (gn < g1) { const int h2 = lin >> 6, n2 = lin & 63, cn2 = (int)cn16[lin], lb2 = list_base(h2, n2), nch2 = (int)pre[lin + 1] - (int)pre[lin], c12 = (g1 - gn < nch2) ? g1 - gn : nch2;
            if (wave * 32 < cn2) { have_pre = true;
                pre_e0 = lists[lb2 + (wave * 32 + r32 < cn2 ? wave * 32 + r32 : wave * 32)]; pre_e1 = 0u;
                if (1 < c12 && 256 + wave * 32 < cn2) pre_e1 = lists[lb2 + (256 + wave * 32 + r32 < cn2 ? 256 + wave * 32 + r32 : 256 + wave * 32)];
                load_q4(pre_q, qh + ((size_t)h2 * SEQ + (pre_e0 >> 2)) * HD, hf); } }
        asm volatile("s_waitcnt lgkmcnt(0)" ::: "memory"); __builtin_amdgcn_s_barrier(); asm volatile("" ::: "memory");
        g = gn; li = lin; b ^= 1;
    }
#undef ATS_ENTRY
}

__device__ __forceinline__ void phase_attown(unsigned char* ws, LAS unsigned char* lds, int tid, int lane, int wave, int G, int vcu, bool nostore) {
    const float* tab = (const float*)(ws + WS_TAB); const f32x2* pml = (const f32x2*)(ws + AT_ML);
    bf16_t* qh = (bf16_t*)(ws + AT_Q); const bf16_t* kh = (const bf16_t*)(ws + AT_K); const bf16_t* vh = (const bf16_t*)(ws + AT_V); const bf16_t* po = (const bf16_t*)(ws + AT_PO);
    LAS float* tabl = (LAS float*)(lds + RING_BYTES + 8448);
    const int sub = wave < 4 ? wave : 11 - wave;
    const int r32 = lane & 31, hf = lane >> 5;
    int it = vcu, b = 0; bf16x8 qf[4] = {};
    __syncthreads();
    if (it < NH * 64) { if (tid < 129) tabl[tid] = tid < 128 ? tab[(it >> 6) * 128 + tid] - tab[(it >> 6) * 128 + 127] : tab[(it >> 6) * 128 + 127];
        load_q4(qf, qh + ((size_t)it * 256 + sub * 32 + r32) * HD, hf);
        dma_kv(lds, kh + (size_t)it * 256 * HD, vh + (size_t)it * 256 * HD, tid, wave); }
    for (; it < NH * 64; it += G) {
        const int nit = it + G;
        if (nit < NH * 64) { if (tid < 129) tabl[(b ^ 1) * 132 + tid] = tid < 128 ? tab[(nit >> 6) * 128 + tid] - tab[(nit >> 6) * 128 + 127] : tab[(nit >> 6) * 128 + 127];
            dma_kv(lds + (b ^ 1) * 65536, kh + (size_t)nit * 256 * HD, vh + (size_t)nit * 256 * HD, tid, wave); asm volatile("s_waitcnt vmcnt(8)" ::: "memory"); }
        else asm volatile("s_waitcnt vmcnt(0)" ::: "memory");
        asm volatile("s_waitcnt lgkmcnt(0)" ::: "memory"); __builtin_amdgcn_s_barrier(); asm volatile("" ::: "memory");
        bf16x8 qn[4] = {};
        if (nit < NH * 64) load_q4(qn, qh + ((size_t)nit * 256 + sub * 32 + r32) * HD, hf);
        const int h = it >> 6, j = it & 63;
        const int t = j * 256 + sub * 32 + r32;
        float m, l; f32x16 o[2];
        if (!(nostore && (PROBE_ATT & 1))) attn_tile<1>(qf, lds + b * 65536, lds + b * 65536 + 32768, tabl + b * 132, j * 256, sub + 1, t, lane, m, l, o); else { m = 0.f; l = 1.f; o[0] = (f32x16){}; o[1] = (f32x16){}; }
        const int nsel = (nostore && (PROBE_ATT & 2)) ? 0 : (j < 3 ? j : 3); const size_t pe = ((size_t)h * SEQ + t) * 3;
        float pm[3], pl[3]; float M = m;
#pragma unroll
        for (int r = 0; r < 3; ++r) { if (r < nsel) { const f32x2 v = pml[pe + r]; pm[r] = v.x; pl[r] = v.y; M = fmaxf(M, v.x); } else { pm[r] = -3.0e38f; pl[r] = 0.f; } }
        const float w4 = fast_exp2(m - M); float L = w4 * l; float wl[3];
#pragma unroll
        for (int r = 0; r < 3; ++r) { wl[r] = r < nsel ? fast_exp2(pm[r] - M) * pl[r] : 0.f; L += wl[r]; }
        const float inv = fast_rcp(L);
        bf16_t* od = qh + ((size_t)h * SEQ + t) * HD + 4 * hf;
#pragma unroll
        for (int dt = 0; dt < 2; ++dt)
#pragma unroll
            for (int gp = 0; gp < 2; ++gp) {
                float a[8];
#pragma unroll
                for (int i = 0; i < 8; ++i) a[i] = o[dt][8 * gp + i] * w4;
#pragma unroll
                for (int r = 0; r < 3; ++r) if (r < nsel) {
                    if (PO8) { const u32x2 v8 = *(const u32x2*)((const unsigned char*)po + (size_t)(pe + r) * HD + 32 * hf + 16 * dt + 8 * gp);
                        const auto f0 = __builtin_amdgcn_cvt_pk_f32_fp8((int)v8.x, false), f1 = __builtin_amdgcn_cvt_pk_f32_fp8((int)v8.x, true), f2 = __builtin_amdgcn_cvt_pk_f32_fp8((int)v8.y, false), f3 = __builtin_amdgcn_cvt_pk_f32_fp8((int)v8.y, true);
                        a[0] += wl[r] * f0[0]; a[1] += wl[r] * f0[1]; a[2] += wl[r] * f1[0]; a[3] += wl[r] * f1[1]; a[4] += wl[r] * f2[0]; a[5] += wl[r] * f2[1]; a[6] += wl[r] * f3[0]; a[7] += wl[r] * f3[1]; continue; }
                    const u32x4 v = *(const u32x4*)(po + (pe + r) * HD + 32 * hf + 16 * dt + 8 * gp);
                    a[0] += wl[r] * bf_lo(v.x); a[1] += wl[r] * bf_hi(v.x); a[2] += wl[r] * bf_lo(v.y); a[3] += wl[r] * bf_hi(v.y);
                    a[4] += wl[r] * bf_lo(v.z); a[5] += wl[r] * bf_hi(v.z); a[6] += wl[r] * bf_lo(v.w); a[7] += wl[r] * bf_hi(v.w); }
                u32x2 w0, w1; w0.x = cvt_pk_bf16(a[0] * inv, a[1] * inv); w0.y = cvt_pk_bf16(a[2] * inv, a[3] * inv); w1.x = cvt_pk_bf16(a[4] * inv, a[5] * inv); w1.y = cvt_pk_bf16(a[6] * inv, a[7] * inv);
                if (!nostore) { st8(od + 32 * dt + 16 * gp, w0); st8(od + 32 * dt + 16 * gp + 8, w1); }
            }
        asm volatile("s_waitcnt lgkmcnt(0)" ::: "memory"); __builtin_amdgcn_s_barrier(); asm volatile("" ::: "memory");
        b ^= 1;
#pragma unroll
        for (int ds = 0; ds < 4; ++ds) qf[ds] = qn[ds];
    }
}

__global__ void __launch_bounds__(NTHREADS, 2) mk_fwd(Args args) {
    extern __shared__ __attribute__((aligned(16))) unsigned char lds_raw[];
    LAS unsigned char* lds = (LAS unsigned char*)lds_raw;
    volatile LAS unsigned* misc = (volatile LAS unsigned*)(lds + RING_BYTES + 8192);
    if (!MK_MULTI) {
        if (threadIdx.x == 0) { const unsigned xcc = xb_xcc_id();
            misc[0] = xcc; misc[1] = xb_add((unsigned*)(args.ws + WS_BAR) + XB_XCNT(xcc), 1u); misc[2] = 0u; misc[3] = 0u; misc[4] = 0u; }
        __syncthreads();
    }
    for (int pp = args.ph_lo; pp < args.ph_hi; ++pp) {
        const int p = (PROBE_DUP >= 0 && pp > PROBE_DUP) ? (pp - PROBE_DUP <= PROBE_REP ? PROBE_DUP : pp - PROBE_REP) : pp; const bool isdup = PROBE_DUP >= 0 && pp > PROBE_DUP && pp - PROBE_DUP <= PROBE_REP;
        size_t wso = 0; asm volatile("" : "+s"(wso)); unsigned char* ws = args.ws + wso;
        int tid = threadIdx.x; asm volatile("" : "+v"(tid));
        int G = gridDim.x, bx = blockIdx.x; asm volatile("" : "+s"(G), "+s"(bx));
        const int lane = tid & 63, wave = __builtin_amdgcn_readfirstlane(tid >> 6);
        int cid = bx, vcu = (G % 8 == 0) ? (bx % 8) * (G / 8) + bx / 8 : bx;
        if (!MK_MULTI && pp > 0 && (G % 8) == 0) {
            if (pp == 1) {
                unsigned* xc = (unsigned*)(ws + WS_BAR); unsigned c8[8];
#pragma unroll
                for (int j = 0; j < 8; ++j) c8[j] = xb_ld(xc + XB_XCNT(j));
                bool ok = true;
#pragma unroll
                for (int j = 0; j < 8; ++j) ok = ok && ((int)c8[j] == G / 8);
                if (threadIdx.x == 0) misc[4] = ok ? 1u : 0u;
                __syncthreads();
            }
            if (misc[4]) { const int xcc = (int)misc[0], rank = (int)misc[1]; cid = rank * 8 + xcc; vcu = xcc * (G / 8) + rank; }
        }
        bx = cid;
        const bool one_panel = !MK_MULTI && G == 256 && misc[4] != 0u;
        int kind;
        switch (p) { case 0: kind = K_PROA; break; case 1: kind = K_PROB; break; case 2: case 8: case 10: case 17: kind = K_FFNIN; break;
            case 3: case 7: case 9: case 11: case 16: case 18: kind = K_RESID; break; case 4: kind = K_GV; break; case 5: kind = K_SPATIAL; break; case 6: kind = K_GU; break;
            case 12: kind = K_QKV; break; case 13: kind = K_TOPK; break; case 14: kind = K_ATTSEL; break; case 15: kind = K_ATTOWN; break; default: kind = K_FINAL; break; }
        LAS float* rst = (LAS float*)(lds + RING_BYTES);
        float* sumsq = (float*)(ws + WS_SUMSQ); bf16_t* xb = (bf16_t*)(ws + WS_XB); bf16_t* big = (bf16_t*)(ws + WS_BIG);

        if (kind == K_PROA) {
            phase_proa(args, ws, lds, tid, lane, wave, G, bx, vcu);
        } else if (kind == K_PROB) {
            phase_prob(args, ws, lds, tid, lane, wave, G, bx, vcu);
        } else if (kind == K_FFNIN) {
            const int w = p == 2 ? 0 : (p == 8 ? 1 : (p == 10 ? 2 : 3));
            const bf16_t* Bt = (const bf16_t*)(ws + ((w >> 1) ? W1_FIN : W0_FIN) + (size_t)(w & 1) * SZ_FIN);
            const bool in8 = (F8_IN17 && p == 17) || (F8_IN10 && p == 10);
            pg8::StaticOrder S; S.init(SEQ, NFF2, G, bx);
            const bool ini8 = ((I8_IN >> w) & 1) && PROBE_DUP < 0;
            rstd_prepass(rst, sumsq, bx & 7, tid, one_panel ? 8 * (bx & 7) + ((bx >> 3) & 7) : -1, in8 ? 1.0f / F8_INSCALE : (ini8 ? I8_XCLIP / 127.0f : 1.0f));
            LAS float* bl = (LAS float*)(lds + RING_BYTES + 10240);
            LAS float* cst = (LAS float*)(lds + 147456);
            if (ini8) {
                const float* csg = (const float*)(ws + WS_CS) + w * NFF2; const int j = tid & 255, i0 = tid >> 8;
#pragma unroll
                for (int q = 0; q < 3; ++q) { pg8::Unit u; if (S.next(i0 + 2 * q, u)) cst[(i0 + 2 * q) * 256 + j] = csg[j < 128 ? u.pn * 128 + j : DFF + u.pn * 128 + (j - 128)]; } }
            bias_prepass(bl, (const float*)(ws + WS_BPART) + BP_F + w * 16 * NFF2, NFF2, 0, true, S, tid);
            if (ini8) {
                pg8::Gemm g{(const bf16_t*)(ws + WS_X8), Bt, SEQ, NFF2, DM / 2, DM / 2, 128};
                pg8::EpiSwiGLUI8 E{(unsigned char*)big, bl, rst, cst};
                pg8::gemm_phase<pg8::EpiSwiGLUI8, true>(lds, g, S, E, tid, isdup);
            } else if (in8) {
                pg8::Gemm g{(const bf16_t*)(ws + WS_X8), Bt, SEQ, NFF2, DM / 2, DM / 2, 128};
                pg8::EpiSwiGLUF8 E{(unsigned char*)big, bl, rst};
                pg8::gemm_phase<pg8::EpiSwiGLUF8, true>(lds, g, S, E, tid, isdup);
            } else {
                pg8::Gemm g{xb, Bt, SEQ, NFF2, DM, DM, 128};
                pg8::EpiSwiGLU E{(unsigned char*)big, bl, rst};
                pg8::gemm_phase<pg8::EpiSwiGLU, true>(lds, g, S, E, tid, isdup);
            }
            if ((p == 2 || p == 8 || p == 10) && !isdup) { const int nfull = S.nwg - (S.nwg / G) * G;
                if (bx >= nfull) {
                    const float* mod = (const float*)(ws + WS_MOD);
                    if (p == 2 || p == 8) { const int wq = p == 2 ? 1 : 3, lay = wq >> 1;
                        for (int it = bx - nfull; it < NFF2 / 32; it += G - nfull)
                            convert_i8_item(args.in[IN_FWIN] + (size_t)wq * DM * NFF2, NFF2, ws + (lay ? W1_FIN : W0_FIN) + SZ_FIN, (LAS float*)(lds + wave * 16384), (LAS float*)(lds + RING_BYTES), it, lane, wave,
                                            args.in[IN_NORMG] + (lay * 3 + 2) * DM, mod + lay * 9216 + (2 * 3 + 1) * DM, mod + lay * 9216 + (2 * 3 + 0) * DM, (float*)(ws + WS_BPART) + BP_F + wq * 16 * NFF2, (float*)(ws + WS_CS) + wq * NFF2);
                    } else convert_outs(args, ws, lds, lane, wave, (bx - nfull) * NWAVES + wave, (G - nfull) * NWAVES, 4 | 8 | 16); } }
        } else if (kind == K_RESID) {
            const int r = p == 3 ? 0 : (p == 7 ? 1 : (p == 9 ? 2 : (p == 11 ? 3 : (p == 16 ? 4 : 5))));
            const float* gate = isdup ? (const float*)(ws + 64 * KiB) : (const float*)(ws + WS_GATE) + r * DM;
            size_t boff = W0_FOUT; if (r == 1) boff = W0_GOUT; if (r == 2) boff = W0_FOUT + SZ_FOUT; if (r == 3) boff = W1_FOUT; if (r == 4) boff = W1_WO; if (r == 5) boff = W1_FOUT + SZ_FOUT;
            const size_t aoffb = r == 4 ? AT_Q : (r == 1 ? WS_ZV : WS_BIG);
            const int Kd = r == 1 ? GMD : (r == 4 ? DM : DFF), lda = r == 4 ? HD : Kd;
            const size_t kst = r == 4 ? (size_t)SEQ * HD * 2 : (size_t)128;
            pg8::StaticOrder S; S.init(SEQ, DM, G, bx);
            const int wn = r == 1 ? 1 : (r == 2 ? 2 : (r == 4 ? 3 : -1)); const bool xi8 = (wn > 0 && ((I8_IN >> wn) & 1)) || (I8_GIN && r == 0);
            unsigned char* x8p = (xi8 || (F8_IN10 && r == 2) || (F8_IN17 && r == 4)) ? ws + WS_X8 : nullptr;
            if (F8_OUT && (r == 0 || r == 2 || r == 3 || r == 5)) {
                pg8::Gemm g{(const bf16_t*)(ws + aoffb), (const bf16_t*)(ws + boff), SEQ, DM, DFF / 2, DFF / 2, (size_t)128};
                pg8::EpiResidF8 E{xb, gate, sumsq, x8p, xi8};
                pg8::gemm_phase<pg8::EpiResidF8, true>(lds, g, S, E, tid, isdup);
            } else {
                pg8::Gemm g{(const bf16_t*)(ws + aoffb), (const bf16_t*)(ws + boff), SEQ, DM, Kd, lda, kst};
                pg8::EpiResid E{xb, gate, sumsq, x8p, xi8};
                pg8::gemm_phase<pg8::EpiResid, true>(lds, g, S, E, tid, isdup);
            }
        } else if (kind == K_GV) {
            pg8::StaticOrder S; S.init(SEQ, GMD, G, bx);
            const bool gi8 = I8_GIN && PROBE_DUP < 0;
            rstd_prepass(rst, sumsq, bx & 7, tid, one_panel ? 8 * (bx & 7) + ((bx >> 3) & 7) : -1, gi8 ? I8_XCLIP / 127.0f : 1.0f);
            LAS float* bl = (LAS float*)(lds + RING_BYTES + 10240); LAS float* cst = (LAS float*)(lds + 147456);
            if (gi8) { const float* csg = (const float*)(ws + WS_CS) + 4 * NFF2 + GMD; const int j = tid & 255, i0 = tid >> 8;
#pragma unroll
                for (int q = 0; q < 3; ++q) { pg8::Unit u; if (S.next(i0 + 2 * q, u)) cst[(i0 + 2 * q) * 256 + j] = csg[u.pn * 256 + j]; } }
            bias_prepass(bl, (const float*)(ws + WS_BPART) + BP_G, 6144, GMD, false, S, tid);
            if (gi8) {
                pg8::Gemm g{(const bf16_t*)(ws + WS_X8), (const bf16_t*)(ws + W0_GIN + (size_t)GMD * DM), SEQ, GMD, DM / 2, DM / 2, 128};
                pg8::EpiGeluVI8 E{cst, (bf16_t*)(ws + WS_ZV), bl, rst, (float*)(ws + WS_VSQ)};
                pg8::gemm_phase<pg8::EpiGeluVI8, true>(lds, g, S, E, tid, isdup);
            } else {
                pg8::Gemm g{xb, (const bf16_t*)(ws + W0_GIN) + (size_t)GMD * DM, SEQ, GMD, DM, DM, 128};
                pg8::EpiGeluV E{cst, (bf16_t*)(ws + WS_ZV), bl, rst, (float*)(ws + WS_VSQ)};
                pg8::gemm_phase<pg8::EpiGeluV, true>(lds, g, S, E, tid, isdup);
            }
        } else if (kind == K_GU) {
            pg8::StaticOrder S; S.init(SEQ, GMD, G, bx);
            const bool gi8 = I8_GIN && PROBE_DUP < 0;
            rstd_prepass(rst, sumsq, bx & 7, tid, one_panel ? 8 * (bx & 7) + ((bx >> 3) & 7) : -1, gi8 ? I8_XCLIP / 127.0f : 1.0f);
            LAS float* bl = (LAS float*)(lds + RING_BYTES + 10240); LAS float* cst = (LAS float*)(lds + 147456);
            if (gi8) { const float* csg = (const float*)(ws + WS_CS) + 4 * NFF2; const int j = tid & 255, i0 = tid >> 8;
#pragma unroll
                for (int q = 0; q < 3; ++q) { pg8::Unit u; if (S.next(i0 + 2 * q, u)) cst[(i0 + 2 * q) * 256 + j] = csg[u.pn * 256 + j]; } }
            bias_prepass(bl, (const float*)(ws + WS_BPART) + BP_G, 6144, 0, false, S, tid);
            if (gi8) {
                pg8::Gemm g{(const bf16_t*)(ws + WS_X8), (const bf16_t*)(ws + W0_GIN), SEQ, GMD, DM / 2, DM / 2, 128};
                pg8::EpiGeluMulI8 E{cst, (bf16_t*)(ws + WS_ZV), bl, rst, isdup};
                pg8::gemm_phase<pg8::EpiGeluMulI8, true>(lds, g, S, E, tid, false);
            } else {
                pg8::Gemm g{xb, (const bf16_t*)(ws + W0_GIN), SEQ, GMD, DM, DM, 128};
                pg8::EpiGeluMul E{cst, (bf16_t*)(ws + WS_ZV), bl, rst, isdup};
                pg8::gemm_phase<pg8::EpiGeluMul, true>(lds, g, S, E, tid, false);
            }
        } else if (kind == K_QKV) {
            pg8::Gemm g{xb, (const bf16_t*)(ws + W1_QKV), SEQ, 3072, DM, DM, 128}; pg8::StaticOrder S; S.init(SEQ, 3072, G, bx);
            rstd_prepass(rst, sumsq, bx & 7, tid, one_panel ? 8 * (bx & 7) + ((bx >> 3) & 7) : -1);
            LAS float* bl = (LAS float*)(lds + RING_BYTES + 10240);
            bias_prepass(bl, (const float*)(ws + WS_BPART) + BP_Q, 3072, 0, false, S, tid);
            pg8::EpiQKV E{(bf16_t*)(ws + AT_Q), bl, rst, (float*)(ws + WS_KSUM)};
            pg8::gemm_phase<pg8::EpiQKV, true>(lds, g, S, E, tid, isdup);
        } else if (kind == K_SPATIAL) {
            phase_spatial(args, ws, lds, tid, lane, wave, G, vcu, isdup);
        } else if (kind == K_TOPK) {
            phase_topk(ws, lds, tid, lane, wave, G, vcu, isdup);
        } else if (kind == K_ATTSEL) {
            phase_attsel(ws, lds, tid, lane, wave, G, vcu, isdup);
        } else if (kind == K_ATTOWN) {
            phase_attown(ws, lds, tid, lane, wave, G, vcu, isdup);
        } else if (p >= NPHASE) {
#if PROBE_MFMA
            { f32x16 a = {}; bf16x8 x = {1, 2, 3, 4, 5, 6, 7, 8}; for (int i = 0; i < PROBE_MFMA; ++i) { a = __builtin_amdgcn_mfma_f32_32x32x16_bf16(x, x, a, 0, 0, 0); }
              if (a[0] == 1.2345f) args.out[0] = a[1]; }
#endif
        } else {
            const int gw = vcu * NWAVES + wave, NGW = G * NWAVES; const float* fn = args.in[IN_FNORM]; float* out = args.out;
            f32x4 fv[4];
#pragma unroll
            for (int j = 0; j < 4; ++j) fv[j] = *(const f32x4*)(fn + 4 * lane + 256 * j);
            const int nrow_f = (G == 256) ? 8 : (SEQ + NGW - 1 - gw) / NGW;
            for (int k0 = 0; k0 < nrow_f; k0 += 4) {
                u32x2 w[4][4]; f32x4 sq[4][4]; int mrow[4];
#pragma unroll
                for (int r = 0; r < 4; ++r) { const int k_f = k0 + r < nrow_f ? k0 + r : k0;
                    mrow[r] = (G == 256) ? (vcu >> 5) * 2048 + (vcu & 31) * 64 + wave * 8 + k_f : gw + k_f * NGW;
                    const u32x2* xr = (const u32x2*)(xb + (size_t)mrow[r] * DM) + lane; const f32x4* sp = (const f32x4*)(sumsq + (size_t)mrow[r] * 16);
#pragma unroll
                    for (int j = 0; j < 4; ++j) { w[r][j] = xr[64 * j]; sq[r][j] = sp[j]; } }
#pragma unroll
                for (int r = 0; r < 4; ++r) if (k0 + r < nrow_f) {
                    float s = 0.f;
#pragma unroll
                    for (int j = 0; j < 4; ++j) s += (sq[r][j].x + sq[r][j].y) + (sq[r][j].z + sq[r][j].w);
                    const float rs = rsqrtf(s * (1.0f / DM) + RMS_EPS); f32x4* orow = (f32x4*)(out + (size_t)mrow[r] * DM) + lane;
#pragma unroll
                    for (int j = 0; j < 4; ++j) orow[64 * j] = (f32x4){bf_lo(w[r][j].x), bf_hi(w[r][j].x), bf_lo(w[r][j].y), bf_hi(w[r][j].y)} * rs * fv[j];
                }
            }
        }
        if (pp + 1 < args.ph_hi) {
            const bool local_ok = !isdup && PROBE_DUP < 0 && misc[4] != 0u && (p == 2 || p == 3 || p == 4 || p == 6 || p == 7 || p == 8 || p == 9 || p == 10 || p == 16 || p == 17 || p == 18) && G == 256;
            if (local_ok && LOCAL_SEAMS) xcd_local_barrier((unsigned*)(args.ws + WS_BAR), misc); else xcd_barrier((unsigned*)(args.ws + WS_BAR), misc);
        }
    }
}

extern "C" void kernel_launch(void* const* d_in, const int* in_sizes, int n_in, void* d_out, int out_size, void* d_ws, size_t ws_size, hipStream_t stream) {
    static int grid = 0;
    if (grid == 0) {
        if (n_in != 16 || in_sizes[0] != SEQ * DM || out_size != SEQ * DM || ws_size < WS_END) { fprintf(stderr, "kernel_launch: unexpected shapes / workspace (%zu < %zu)\n", ws_size, (size_t)WS_END); grid = -1; return; }
        int dev = 0, cus = 0, per_cu = 0;
        hipGetDevice(&dev); hipDeviceGetAttribute(&cus, hipDeviceAttributeMultiprocessorCount, dev);
        hipFuncSetAttribute((const void*)mk_fwd, hipFuncAttributeMaxDynamicSharedMemorySize, LDS_BYTES);
        hipOccupancyMaxActiveBlocksPerMultiprocessor(&per_cu, (const void*)mk_fwd, NTHREADS, LDS_BYTES);
        if (per_cu < 1) { fprintf(stderr, "kernel_launch: occupancy query says %d blocks per CU\n", per_cu); grid = -1; return; }
        grid = cus - (cus % 8);
        (void)hipGetLastError();
    }
    if (grid < 0) return;
    hipMemsetAsync((char*)d_ws + WS_CTL, 0, CTL_BYTES, stream);
    Args a{};
    for (int i = 0; i < 16; ++i) a.in[i] = (const float*)d_in[i];
    a.out = (float*)d_out; a.ws = (unsigned char*)d_ws;
#if MK_MULTI
    for (int p = 0; p < NPHASE; ++p) { a.ph_lo = p; a.ph_hi = p + 1; hipLaunchKernelGGL(mk_fwd, dim3(grid), dim3(NTHREADS), LDS_BYTES, stream, a); }
#else
    a.ph_lo = 0; a.ph_hi = NPHASE + (PROBE_DUP >= 0 ? PROBE_REP : 0) + PROBE_NOPS;
    void* kargs[] = {&a};
    hipError_t e = hipLaunchCooperativeKernel((const void*)mk_fwd, dim3(grid), dim3(NTHREADS), kargs, LDS_BYTES, stream);
    if (e != hipSuccess) fprintf(stderr, "cooperative launch failed: %s (grid %d)\n", hipGetErrorString(e), grid);
#endif
}
```
